# Optimizing an MI355X kernel written in HIP

```python
import jax, jax.numpy as jnp
from jax import lax
import numpy as np

D_MODEL = 4096
BATCH = 1
SEQ = 8192
DEPTH = 1

CHUNK = 64

FOX_HEAD_DIM = 128
FOX_WIDTH = D_MODEL // 2
FOX_HEADS = FOX_WIDTH // FOX_HEAD_DIM
Q_BLOCK = 128

POOL_WINDOWS = (2, 4, 8, 16)
POOL_GROUPS = len(POOL_WINDOWS)
POOL_WIDTH = D_MODEL // 2
POOL_GROUP_DIM = POOL_WIDTH // POOL_GROUPS
POOL_OUT_GROUP = D_MODEL // POOL_GROUPS

N_BRANCHES = 2
IN_COLS = 3 * FOX_WIDTH + FOX_HEADS + POOL_WIDTH + N_BRANCHES * D_MODEL

FFN_HIDDEN = -(-(8 * D_MODEL) // (3 * 256)) * 256

ALPHA = (2 * DEPTH) ** 0.25
BETA = (8 * DEPTH) ** -0.25
LN_EPS = 1e-5

kernel_name = "hybrid_fox_pool_deepnorm_adaln_block"


def _layer_norm(x, gain=None, bias=None):
    xf = x.astype(jnp.float32)
    mu = jnp.mean(xf, axis=-1, keepdims=True)
    var = jnp.mean(jnp.square(xf - mu), axis=-1, keepdims=True)
    y = (xf - mu) * lax.rsqrt(var + LN_EPS)
    if gain is not None:
        y = y * gain.astype(jnp.float32) + bias.astype(jnp.float32)
    return y.astype(x.dtype)


def _fox_attention(q, k, v, fcum):
    B, S, H, Dh = q.shape
    nb = S // Q_BLOCK
    scale = Dh ** -0.5
    kh = k.transpose(0, 2, 1, 3)
    vh = v.transpose(0, 2, 1, 3)
    fk = fcum.transpose(0, 2, 1)
    qb = q.reshape(B, nb, Q_BLOCK, H, Dh).transpose(1, 0, 3, 2, 4)
    fq = fk.reshape(B, H, nb, Q_BLOCK).transpose(2, 0, 1, 3)
    k_pos = jnp.arange(S)

    def one_block(args):
        q_blk, fq_blk, blk = args
        q_pos = blk * Q_BLOCK + jnp.arange(Q_BLOCK)
        logits = jnp.einsum('bhqd,bhkd->bhqk', q_blk, kh).astype(jnp.float32) * scale
        logits = logits + (fq_blk[..., :, None] - fk[..., None, :])
        mask = k_pos[None, :] <= q_pos[:, None]
        logits = jnp.where(mask, logits, -jnp.inf)
        probs = jax.nn.softmax(logits, axis=-1)
        return jnp.einsum('bhqk,bhkd->bhqd', probs.astype(vh.dtype), vh)

    out = lax.map(one_block, (qb, fq, jnp.arange(nb)))
    return out.transpose(1, 0, 3, 2, 4).reshape(B, S, H * Dh)


def _multiscale_pool(p, w_pool, pool_scale):
    B, S, _ = p.shape
    pg = p.reshape(B, S, POOL_GROUPS, POOL_GROUP_DIM).astype(jnp.float32)
    csum = jnp.cumsum(pg, axis=1)
    t = jnp.arange(S)
    outs = []
    for g, w in enumerate(POOL_WINDOWS):
        cg = csum[:, :, g]
        lag = jnp.pad(cg, ((0, 0), (w, 0), (0, 0)))[:, :S]
        cnt = jnp.minimum(t + 1, w).astype(jnp.float32)[None, :, None]
        outs.append((cg - lag) / cnt - pg[:, :, g])
    pooled = jnp.stack(outs, axis=2).astype(p.dtype)
    y = jnp.einsum('bsgc,gce->bsge', pooled, w_pool).reshape(B, S, D_MODEL)
    return y * pool_scale


def _token_mixer(u, w_in, b_forget, w_attn_out, w_pool, pool_scale, w_out):
    B, S, _ = u.shape
    z = u @ w_in
    F, H = FOX_WIDTH, FOX_HEADS
    o1 = 3 * F
    o2 = o1 + H
    o3 = o2 + POOL_WIDTH
    o4 = o3 + D_MODEL
    q = z[..., 0:F].reshape(B, S, H, FOX_HEAD_DIM)
    k = z[..., F:2 * F].reshape(B, S, H, FOX_HEAD_DIM)
    v = z[..., 2 * F:o1].reshape(B, S, H, FOX_HEAD_DIM)
    f_logit = z[..., o1:o2].astype(jnp.float32) + b_forget.astype(jnp.float32)
    p = z[..., o2:o3]
    gate_a = jax.nn.sigmoid(z[..., o3:o4])
    gate_p = jax.nn.sigmoid(z[..., o4:])

    fcum = jnp.cumsum(jax.nn.log_sigmoid(f_logit), axis=1)
    y_a = _fox_attention(q, k, v, fcum) @ w_attn_out
    y_p = _multiscale_pool(p, w_pool, pool_scale)
    return (gate_a * y_a + gate_p * y_p) @ w_out


def _swiglu(u, w_gate_up, w_down):
    h = u @ w_gate_up
    g, up = h[..., :FFN_HIDDEN], h[..., FFN_HIDDEN:]
    return (jax.nn.silu(g) * up) @ w_down


def setup_inputs(seed: int = 0) -> dict:
    key = jax.random.key(seed)
    ks = jax.random.split(key, 17)
    L, D = DEPTH, D_MODEL
    nrm = lambda k, shape: jax.random.normal(k, shape, jnp.float32)
    x = nrm(ks[0], (BATCH, SEQ, D))
    c = nrm(ks[1], (BATCH, D))
    w_ada = nrm(ks[2], (L, D, 6 * D)) * (0.5 * D ** -0.5)
    b_ada = nrm(ks[3], (L, 6 * D)) * 0.02
    col_scale = jnp.ones((IN_COLS,), jnp.float32).at[2 * FOX_WIDTH:3 * FOX_WIDTH].set(BETA)
    w_in = nrm(ks[4], (L, D, IN_COLS)) * (D ** -0.5) * col_scale
    b_forget = (jnp.linspace(1.0, 6.0, FOX_HEADS, dtype=jnp.float32)[None, :]
                + 0.1 * nrm(ks[5], (L, FOX_HEADS)))
    w_attn_out = nrm(ks[6], (L, FOX_WIDTH, D)) * FOX_WIDTH ** -0.5
    w_pool = nrm(ks[7], (L, POOL_GROUPS, POOL_GROUP_DIM, POOL_OUT_GROUP)) * POOL_GROUP_DIM ** -0.5
    pool_scale = 1.0 + 0.1 * nrm(ks[8], (L, D))
    w_out = nrm(ks[9], (L, D, D)) * (D ** -0.5) * BETA
    ln1_g = 1.0 + 0.02 * nrm(ks[10], (L, D))
    ln1_b = 0.02 * nrm(ks[11], (L, D))
    w_gate_up = nrm(ks[12], (L, D, 2 * FFN_HIDDEN)) * D ** -0.5
    w_down = nrm(ks[13], (L, FFN_HIDDEN, D)) * (FFN_HIDDEN ** -0.5) * BETA
    ln2_g = 1.0 + 0.02 * nrm(ks[14], (L, D))
    ln2_b = 0.02 * nrm(ks[15], (L, D))
    return {"x": x, "c": c, "w_ada": w_ada, "b_ada": b_ada, "w_in": w_in,
            "b_forget": b_forget, "w_attn_out": w_attn_out, "w_pool": w_pool,
            "pool_scale": pool_scale, "w_out": w_out, "ln1_g": ln1_g, "ln1_b": ln1_b,
            "w_gate_up": w_gate_up, "w_down": w_down, "ln2_g": ln2_g, "ln2_b": ln2_b}


def reference(x, c, w_ada, b_ada, w_in, b_forget, w_attn_out, w_pool, pool_scale,
              w_out, ln1_g, ln1_b, w_gate_up, w_down, ln2_g, ln2_b):
    D = D_MODEL
    for l in range(DEPTH):
        mod = (jax.nn.silu(c) @ w_ada[l] + b_ada[l])[:, None, :]
        sh1, sc1, g1 = mod[..., 0:D], mod[..., D:2 * D], mod[..., 2 * D:3 * D]
        sh2, sc2, g2 = mod[..., 3 * D:4 * D], mod[..., 4 * D:5 * D], mod[..., 5 * D:]
        u = _layer_norm(x) * (1.0 + sc1) + sh1
        m = _token_mixer(u, w_in[l], b_forget[l], w_attn_out[l], w_pool[l],
                         pool_scale[l], w_out[l])
        x = _layer_norm(ALPHA * x + g1 * m, ln1_g[l], ln1_b[l])
        u = _layer_norm(x) * (1.0 + sc2) + sh2
        f = _swiglu(u, w_gate_up[l], w_down[l])
        x = _layer_norm(ALPHA * x + g2 * f, ln2_g[l], ln2_b[l])
    return x
```

```cpp
#include <hip/hip_runtime.h>
#include <cstdio>
#include <cstdint>

#define GAS __attribute__((address_space(1)))
#define LAS __attribute__((address_space(3)))
typedef unsigned short bf16;
typedef short bf16x8 __attribute__((ext_vector_type(8)));
typedef short s16x4 __attribute__((ext_vector_type(4)));
typedef float f32x4 __attribute__((ext_vector_type(4)));
typedef float f32x16 __attribute__((ext_vector_type(16)));
typedef unsigned u32x4 __attribute__((ext_vector_type(4)));
typedef unsigned u32x2 __attribute__((ext_vector_type(2)));

constexpr int S = 8192, D = 4096, NH = 16, HD = 128, FW = 2048, PW = 2048, FFN = 11008, INC = 16400, D6 = 6 * D;
constexpr int NZ = 16384;
constexpr int NGU = 2 * FFN;
constexpr float LN_EPS = 1e-5f;
constexpr float ALPHA = 1.189207115002721f;
constexpr float ATT_SCALE = 0.08838834764831845f;
constexpr float INV_ATT_SCALE = 11.313708498984761f;
constexpr int NWAVES = 8, NTHREADS = 512;

constexpr size_t MiB = 1u << 20;
constexpr size_t WS_CTL = 0;
constexpr size_t WS_MODP = 1 * MiB;
constexpr size_t WS_MOD = 2 * MiB;
constexpr size_t WS_FL = 3 * MiB;
constexpr size_t WS_BK = 4 * MiB;
constexpr size_t WS_WF = 5 * MiB;
constexpr size_t WS_WZ = 8 * MiB;
constexpr size_t WS_WA = WS_WZ + 128 * MiB;
constexpr size_t WS_WP = WS_WA + 16 * MiB;
constexpr size_t WS_WO = WS_WP + 4 * MiB;
constexpr size_t WS_WGU = WS_WO + 32 * MiB;
constexpr size_t WS_WD = WS_WGU + 172 * MiB;
constexpr size_t WS_U = WS_WD + 86 * MiB;
constexpr size_t WS_QH = WS_U + 64 * MiB;
constexpr size_t WS_KH = WS_QH + 32 * MiB;
constexpr size_t WS_VH = WS_KH + 32 * MiB;
constexpr size_t WS_VT = WS_VH + 32 * MiB;
constexpr size_t WS_PP = WS_VT + 32 * MiB;
constexpr size_t WS_GA = WS_PP + 32 * MiB;
constexpr size_t WS_GP = WS_GA + 64 * MiB;
constexpr size_t WS_ACT = WS_QH;
constexpr size_t WS_PL = WS_GP + 64 * MiB;
constexpr size_t WS_AO = WS_PL + 32 * MiB;
constexpr size_t WS_T = WS_AO + 32 * MiB;
constexpr size_t WS_MX = WS_T + 128 * MiB;
constexpr size_t WS_Y = WS_MX + 64 * MiB;
constexpr size_t WS_X1 = WS_Y + 128 * MiB;
constexpr size_t WS_END = WS_X1 + 128 * MiB;
static_assert(WS_QH + 172 * MiB <= WS_GP && WS_KH == WS_QH + 32 * MiB && WS_VH == WS_KH + 32 * MiB, "ACT overlay / QKV contiguity");

constexpr int LDS_BYTES = 147456;

__device__ __forceinline__ unsigned cvt_pk_bf16(float lo, float hi) { unsigned r; asm volatile("v_cvt_pk_bf16_f32 %0, %1, %2" : "=v"(r) : "v"(lo), "v"(hi)); return r; }
__device__ __forceinline__ bf16 f2bf(float f) { return (bf16)(cvt_pk_bf16(f, 0.f) & 0xffffu); }
__device__ __forceinline__ float bf2f(bf16 b) { return __uint_as_float(((unsigned)b) << 16); }
__device__ __forceinline__ float wave_sum(float v) {
#pragma unroll
    for (int o = 1; o < 64; o <<= 1) v += __shfl_xor(v, o);
    return v;
}
__device__ __forceinline__ float sigmoidf_(float x) { return 1.0f / (1.0f + __expf(-x)); }
#define LDS_WAIT() asm volatile("s_waitcnt lgkmcnt(0)" ::: "memory")
#define VM_WAIT() asm volatile("s_waitcnt vmcnt(0)" ::: "memory")

struct Ctx {
    LAS unsigned char* lds;
    int tid, lane, wave, G;
    const float *x, *c, *w_ada, *b_ada, *w_in, *b_forget, *w_attn_out, *w_pool, *pool_scale, *w_out, *ln1_g, *ln1_b, *w_gate_up, *w_down, *ln2_g, *ln2_b;
    float* out;
    unsigned char* ws;
};
#define WSP(T, off) ((T*)(C.ws + (off)))

__device__ __forceinline__ void conv_item(const float* W, int ldw, int k0, int srcn0, bf16* dst, int ldd, int dstr0, const float* rscale, LAS float* scr, int lane) {
#pragma unroll 8
    for (int i = 0; i < 32; ++i) { const int kk = 2 * i + (lane >> 5); scr[kk * 33 + (lane & 31)] = W[(size_t)(k0 + kk) * ldw + srcn0 + (lane & 31)]; }
    LDS_WAIT(); asm volatile("" ::: "memory");
    const int c = lane & 7;
#pragma unroll
    for (int j = 0; j < 4; ++j) { const int n = (lane >> 3) + 8 * j; const LAS float* s = scr + (8 * c) * 33 + n;
        const float sc = rscale ? rscale[dstr0 + n] : 1.0f;
        u32x4 o; o.x = cvt_pk_bf16(s[0 * 33] * sc, s[1 * 33] * sc); o.y = cvt_pk_bf16(s[2 * 33] * sc, s[3 * 33] * sc); o.z = cvt_pk_bf16(s[4 * 33] * sc, s[5 * 33] * sc); o.w = cvt_pk_bf16(s[6 * 33] * sc, s[7 * 33] * sc);
        *(u32x4*)(dst + (size_t)(dstr0 + n) * ldd + k0 + 8 * c) = o; }
    LDS_WAIT(); asm volatile("" ::: "memory");
}

__device__ __forceinline__ void ph_prologue(Ctx& C) {
    {
        LAS float* sl = (LAS float*)C.lds;
        LAS float* red = sl + 512;
        float* modp = WSP(float, WS_MODP);
        for (int task = blockIdx.x; task < 256; task += C.G) {
            const int kg = task >> 5, cs = task & 31;
            { const float cv = C.c[512 * kg + C.tid]; sl[C.tid] = cv / (1.0f + __expf(-cv)); }
            __syncthreads();
            f32x4 acc[3] = {};
            const f32x4* wrow = (const f32x4*)(C.w_ada + (size_t)(512 * kg + 64 * C.wave) * D6) + cs * 192 + C.lane;
#pragma unroll 4
            for (int r = 0; r < 64; ++r) { const float s = sl[64 * C.wave + r];
#pragma unroll
                for (int q = 0; q < 3; ++q) { const f32x4 v = wrow[(size_t)r * (D6 / 4) + 64 * q]; acc[q] += v * s; } }
#pragma unroll
            for (int q = 0; q < 3; ++q) *(LAS f32x4*)(red + C.wave * 768 + (C.lane + 64 * q) * 4) = acc[q];
            __syncthreads();
            if (C.tid < 192) { f32x4 s = {0.f, 0.f, 0.f, 0.f};
#pragma unroll
                for (int w = 0; w < 8; ++w) s += *(LAS f32x4*)(red + w * 768 + C.tid * 4);
                *(f32x4*)(modp + (size_t)kg * D6 + cs * 768 + C.tid * 4) = s; }
            __syncthreads();
        }
    }
    {
        LAS float* scr = (LAS float*)(C.lds + C.wave * 16384);
        const int gw = blockIdx.x * NWAVES + C.wave, NGW = C.G * NWAVES;
        constexpr int I_ZA = 64 * 192, I_ZB = 64 * 320, I_A = 32 * 128, I_P = 4 * 8 * 32, I_O = 64 * 128, I_GU = 64 * 688, I_D = 172 * 128;
        constexpr int NITEMS = I_ZA + I_ZB + I_A + I_P + I_O + I_GU + I_D;
        for (int it = gw; it < NITEMS; it += NGW) {
            int r = it;
            if (r < I_GU) { const int kb = r / 688, nb = r % 688, r0 = 32 * nb, tile = r0 >> 8, within = r0 & 255, half = within >> 7, j0 = tile * 128 + (within & 127);
                conv_item(C.w_gate_up, NGU, 64 * kb, half * FFN + j0, WSP(bf16, WS_WGU), D, r0, nullptr, scr, C.lane); continue; } r -= I_GU;
            if (r < I_D) { const int kb = r / 128, nb = r % 128; conv_item(C.w_down, D, 64 * kb, 32 * nb, WSP(bf16, WS_WD), FFN, 32 * nb, nullptr, scr, C.lane); continue; } r -= I_D;
            if (r < I_O) { const int kb = r / 128, nb = r % 128; conv_item(C.w_out, D, 64 * kb, 32 * nb, WSP(bf16, WS_WO), D, 32 * nb, nullptr, scr, C.lane); continue; } r -= I_O;
            if (r < I_A) { const int kb = r / 128, nb = r % 128; conv_item(C.w_attn_out, D, 64 * kb, 32 * nb, WSP(bf16, WS_WA), FW, 32 * nb, nullptr, scr, C.lane); continue; } r -= I_A;
            if (r < I_P) { const int g = r / 256, rr = r % 256, kb = rr / 32, nb = rr % 32;
                conv_item(C.w_pool + (size_t)g * 512 * 1024, 1024, 64 * kb, 32 * nb, WSP(bf16, WS_WP), 512, 1024 * g + 32 * nb, C.pool_scale, scr, C.lane); continue; } r -= I_P;
            if (r < I_ZA) { const int kb = r / 192, nb = r % 192; conv_item(C.w_in, INC, 64 * kb, 32 * nb, WSP(bf16, WS_WZ), D, 32 * nb, nullptr, scr, C.lane); continue; } r -= I_ZA;
            { const int kb = r / 320, nb = r % 320; conv_item(C.w_in, INC, 64 * kb, 6160 + 32 * nb, WSP(bf16, WS_WZ), D, 6144 + 32 * nb, nullptr, scr, C.lane); }
        }
        bf16* wf = WSP(bf16, WS_WF);
        for (int g = blockIdx.x * NTHREADS + C.tid; g < 16 * D; g += C.G * NTHREADS) { const int h = g & 15, k = g >> 4; wf[h * D + k] = f2bf(C.w_in[(size_t)k * INC + 6144 + h]); }
    }
}

__device__ __forceinline__ void row_load(const float* rowp, int lane, f32x4 (&v)[16]) {
    const f32x4* p = (const f32x4*)rowp + lane;
#pragma unroll
    for (int j = 0; j < 16; ++j) v[j] = p[64 * j];
}
__device__ __forceinline__ void row_normalize(f32x4 (&v)[16]) {
    float s = 0.f;
#pragma unroll
    for (int j = 0; j < 16; ++j) s += (v[j].x + v[j].y) + (v[j].z + v[j].w);
    const float mean = wave_sum(s) * (1.0f / D); float s2 = 0.f;
#pragma unroll
    for (int j = 0; j < 16; ++j) { v[j] = v[j] - mean; s2 += (v[j].x * v[j].x + v[j].y * v[j].y) + (v[j].z * v[j].z + v[j].w * v[j].w); }
    const float rstd = 1.0f / sqrtf(wave_sum(s2) * (1.0f / D) + LN_EPS);
#pragma unroll
    for (int j = 0; j < 16; ++j) v[j] = v[j] * rstd;
}
__device__ __forceinline__ void mod_to_lds(Ctx& C, LAS float* dst, int chunk, float add) {
    const float* modp = WSP(float, WS_MODP);
    for (int c = C.tid; c < D; c += NTHREADS) { float s = C.b_ada[chunk * D + c];
#pragma unroll
        for (int kg = 0; kg < 8; ++kg) s += modp[(size_t)kg * D6 + chunk * D + c];
        dst[c] = s + add; }
}

__device__ __forceinline__ void ph_ln1(Ctx& C) {
    LAS float* sc = (LAS float*)C.lds; LAS float* sh = sc + D;
    mod_to_lds(C, sh, 0, 0.f); mod_to_lds(C, sc, 1, 1.f);
    { const float* modp = WSP(float, WS_MODP); float* mod = WSP(float, WS_MOD);
      for (int j = blockIdx.x * NTHREADS + C.tid; j < D6; j += C.G * NTHREADS) { float s = C.b_ada[j];
#pragma unroll
          for (int kg = 0; kg < 8; ++kg) s += modp[(size_t)kg * D6 + j];
          mod[j] = s; } }
    __syncthreads();
    bf16* U = WSP(bf16, WS_U);
    for (int row = blockIdx.x * NWAVES + C.wave; row < S; row += C.G * NWAVES) {
        f32x4 v[16]; row_load(C.x + (size_t)row * D, C.lane, v); row_normalize(v);
        u32x2* o = (u32x2*)(U + (size_t)row * D) + C.lane;
#pragma unroll
        for (int j = 0; j < 16; ++j) { const f32x4 a = *(LAS f32x4*)(sc + 4 * (C.lane + 64 * j)), b = *(LAS f32x4*)(sh + 4 * (C.lane + 64 * j)); const f32x4 r = v[j] * a + b;
            u32x2 w; w.x = cvt_pk_bf16(r.x, r.y); w.y = cvt_pk_bf16(r.z, r.w); o[64 * j] = w; }
    }
}
__device__ __forceinline__ void ph_ln_mid(Ctx& C) {
    LAS float* g = (LAS float*)C.lds; LAS float* b = g + D; LAS float* sc = b + D; LAS float* sh = sc + D;
    const float* mod = WSP(float, WS_MOD);
    for (int c = C.tid; c < D; c += NTHREADS) { g[c] = C.ln1_g[c]; b[c] = C.ln1_b[c]; sh[c] = mod[3 * D + c]; sc[c] = 1.0f + mod[4 * D + c]; }
    __syncthreads();
    bf16* U = WSP(bf16, WS_U); const float* Y = WSP(float, WS_Y); float* X1 = WSP(float, WS_X1);
    for (int row = blockIdx.x * NWAVES + C.wave; row < S; row += C.G * NWAVES) {
        f32x4 v[16]; row_load(Y + (size_t)row * D, C.lane, v); row_normalize(v);
        f32x4* xo = (f32x4*)(X1 + (size_t)row * D) + C.lane;
#pragma unroll
        for (int j = 0; j < 16; ++j) { const f32x4 a = *(LAS f32x4*)(g + 4 * (C.lane + 64 * j)), bb = *(LAS f32x4*)(b + 4 * (C.lane + 64 * j)); v[j] = v[j] * a + bb; xo[64 * j] = v[j]; }
        row_normalize(v);
        u32x2* o = (u32x2*)(U + (size_t)row * D) + C.lane;
#pragma unroll
        for (int j = 0; j < 16; ++j) { const f32x4 a = *(LAS f32x4*)(sc + 4 * (C.lane + 64 * j)), bb = *(LAS f32x4*)(sh + 4 * (C.lane + 64 * j)); const f32x4 r = v[j] * a + bb;
            u32x2 w; w.x = cvt_pk_bf16(r.x, r.y); w.y = cvt_pk_bf16(r.z, r.w); o[64 * j] = w; }
    }
}
__device__ __forceinline__ void ph_ln_final(Ctx& C) {
    LAS float* g = (LAS float*)C.lds; LAS float* b = g + D;
    for (int c = C.tid; c < D; c += NTHREADS) { g[c] = C.ln2_g[c]; b[c] = C.ln2_b[c]; }
    __syncthreads();
    const float* Y = WSP(float, WS_Y);
    for (int row = blockIdx.x * NWAVES + C.wave; row < S; row += C.G * NWAVES) {
        f32x4 v[16]; row_load(Y + (size_t)row * D, C.lane, v); row_normalize(v);
        f32x4* xo = (f32x4*)(C.out + (size_t)row * D) + C.lane;
#pragma unroll
        for (int j = 0; j < 16; ++j) { const f32x4 a = *(LAS f32x4*)(g + 4 * (C.lane + 64 * j)), bb = *(LAS f32x4*)(b + 4 * (C.lane + 64 * j)); xo[64 * j] = v[j] * a + bb; }
    }
}

__device__ __forceinline__ void ph_flogit(Ctx& C) {
    const bf16* U = WSP(bf16, WS_U); const bf16* WF = WSP(bf16, WS_WF); float* FL = WSP(float, WS_FL);
    LAS float* red = (LAS float*)C.lds;
    const int fr = C.lane & 15, fq = C.lane >> 4, rg = C.wave >> 2, kq = C.wave & 3;
    for (int blk = blockIdx.x; blk < S / 32; blk += C.G) {
        const int row = 32 * blk + 16 * rg + fr;
        const bf16* ap = U + (size_t)row * D + 1024 * kq + 8 * fq; const bf16* bp = WF + (size_t)fr * D + 1024 * kq + 8 * fq;
        f32x4 acc = {0.f, 0.f, 0.f, 0.f};
#pragma unroll 8
        for (int k = 0; k < 32; ++k) { const bf16x8 a = *(const bf16x8*)(ap + 32 * k), b = *(const bf16x8*)(bp + 32 * k); acc = __builtin_amdgcn_mfma_f32_16x16x32_bf16(a, b, acc, 0, 0, 0); }
        *(LAS f32x4*)(red + C.wave * 256 + C.lane * 4) = acc;
        __syncthreads();
        if (kq == 0) { f32x4 s = acc;
#pragma unroll
            for (int w = 1; w < 4; ++w) s += *(LAS f32x4*)(red + (C.wave + w) * 256 + C.lane * 4);
            s += C.b_forget[fr];
            *(f32x4*)(FL + (size_t)fr * S + 32 * blk + 16 * rg + 4 * fq) = s; }
        __syncthreads();
    }
}

__device__ __forceinline__ void ph_scan_pool(Ctx& C) {
    LAS float* wsum = (LAS float*)C.lds;
    for (int h = blockIdx.x; h < NH; h += C.G) {
        const float* fl = WSP(float, WS_FL) + (size_t)h * S; float* bk = WSP(float, WS_BK) + (size_t)h * S;
        float v[16];
#pragma unroll
        for (int q = 0; q < 4; ++q) { const f32x4 t = *(const f32x4*)(fl + 16 * C.tid + 4 * q); v[4 * q] = t.x; v[4 * q + 1] = t.y; v[4 * q + 2] = t.z; v[4 * q + 3] = t.w; }
        float run = 0.f;
#pragma unroll
        for (int i = 0; i < 16; ++i) { const float xx = v[i]; const float ls = -(fmaxf(-xx, 0.f) + log1pf(__expf(-fabsf(xx)))); run += ls; v[i] = run; }
        float incl = run;
#pragma unroll
        for (int o = 1; o < 64; o <<= 1) { const float t = __shfl_up(incl, o); if (C.lane >= o) incl += t; }
        if (C.lane == 63) wsum[C.wave] = incl;
        __syncthreads();
        float off = incl - run;
        for (int w = 0; w < C.wave; ++w) off += wsum[w];
#pragma unroll
        for (int q = 0; q < 4; ++q) { f32x4 t; t.x = -(v[4 * q] + off) * INV_ATT_SCALE; t.y = -(v[4 * q + 1] + off) * INV_ATT_SCALE; t.z = -(v[4 * q + 2] + off) * INV_ATT_SCALE; t.w = -(v[4 * q + 3] + off) * INV_ATT_SCALE;
            *(f32x4*)(bk + 16 * C.tid + 4 * q) = t; }
        __syncthreads();
    }
    const bf16* PP = WSP(bf16, WS_PP); bf16* PL = WSP(bf16, WS_PL);
    for (int gt = blockIdx.x * NTHREADS + C.tid; gt < (S / 16) * (PW / 8); gt += C.G * NTHREADS) {
        const int cc = gt & 255, rc = gt >> 8, g = cc >> 6, w = 2 << g, r0 = 16 * rc;
        const bf16* base = PP + 8 * cc; float sum[8] = {0.f, 0.f, 0.f, 0.f, 0.f, 0.f, 0.f, 0.f};
        for (int j = 1; j < w; ++j) { const int r = r0 - j; if (r >= 0) { const bf16x8 t = *(const bf16x8*)(base + (size_t)r * PW);
#pragma unroll
                for (int e = 0; e < 8; ++e) sum[e] += bf2f((bf16)t[e]); } }
        for (int i = 0; i < 16; ++i) { const int r = r0 + i; const bf16x8 t = *(const bf16x8*)(base + (size_t)r * PW);
            const float inv = 1.0f / (float)((r + 1) < w ? (r + 1) : w); float o[8];
#pragma unroll
            for (int e = 0; e < 8; ++e) { const float pv = bf2f((bf16)t[e]); sum[e] += pv; o[e] = sum[e] * inv - pv; }
            u32x4 ow; ow.x = cvt_pk_bf16(o[0], o[1]); ow.y = cvt_pk_bf16(o[2], o[3]); ow.z = cvt_pk_bf16(o[4], o[5]); ow.w = cvt_pk_bf16(o[6], o[7]);
            *(u32x4*)(PL + (size_t)r * PW + 8 * cc) = ow;
            const int ro = r - w + 1; if (ro >= 0) { const bf16x8 t2 = *(const bf16x8*)(base + (size_t)ro * PW);
#pragma unroll
                for (int e = 0; e < 8; ++e) sum[e] -= bf2f((bf16)t2[e]); } }
    }
}

template <bool PAIR, class Epi>
__device__ __forceinline__ void sgemm_phase(Ctx& C, const bf16* A, int lda, const bf16* Bt, int ldb, int M, int N, int K, int grp_cols, int grp_off, const Epi& E) {
    const int fr = C.lane & 15, fq = C.lane >> 4, wm = C.wave >> 2, wn = C.wave & 3;
    const int nTn = N / 256, nT = (M / 128) * nTn;
    for (int t = blockIdx.x; t < nT; t += C.G) {
        const int tm = t / nTn, tn = t % nTn, row0 = tm * 128 + wm * 64;
        const bf16* Ab = A + (size_t)((tn * 256) / grp_cols) * grp_off;
        int brow[4];
#pragma unroll
        for (int j = 0; j < 4; ++j) brow[j] = PAIR ? (tn * 256 + (j >> 1) * 128 + wn * 32 + (j & 1) * 16 + fr) : (tn * 256 + wn * 64 + 16 * j + fr);
        f32x4 acc[4][4];
#pragma unroll
        for (int i = 0; i < 4; ++i)
#pragma unroll
            for (int j = 0; j < 4; ++j) acc[i][j] = (f32x4){0.f, 0.f, 0.f, 0.f};
        for (int k0 = 0; k0 < K; k0 += 32) {
            bf16x8 a[4], b[4];
#pragma unroll
            for (int i = 0; i < 4; ++i) a[i] = *(const bf16x8*)(Ab + (size_t)(row0 + 16 * i + fr) * lda + k0 + 8 * fq);
#pragma unroll
            for (int j = 0; j < 4; ++j) b[j] = *(const bf16x8*)(Bt + (size_t)brow[j] * ldb + k0 + 8 * fq);
#pragma unroll
            for (int i = 0; i < 4; ++i)
#pragma unroll
                for (int j = 0; j < 4; ++j) acc[i][j] = __builtin_amdgcn_mfma_f32_16x16x32_bf16(a[i], b[j], acc[i][j], 0, 0, 0);
        }
        if constexpr (PAIR) {
#pragma unroll
            for (int i = 0; i < 4; ++i)
#pragma unroll
                for (int j = 0; j < 2; ++j)
#pragma unroll
                    for (int e = 0; e < 4; ++e) E(row0 + 16 * i + 4 * fq + e, tn * 128 + wn * 32 + j * 16 + fr, acc[i][j][e], acc[i][j + 2][e]);
        } else {
#pragma unroll
            for (int i = 0; i < 4; ++i)
#pragma unroll
                for (int j = 0; j < 4; ++j)
#pragma unroll
                    for (int e = 0; e < 4; ++e) E(row0 + 16 * i + 4 * fq + e, tn * 256 + wn * 64 + 16 * j + fr, acc[i][j][e]);
        }
    }
}

__device__ __forceinline__ int crow(int r, int hi) { return (r & 3) + 8 * (r >> 2) + 4 * hi; }
__device__ __forceinline__ void ph_attn_simple(Ctx& C) {
    const bf16* QH = WSP(bf16, WS_QH); const bf16* KH = WSP(bf16, WS_KH); const bf16* VT = WSP(bf16, WS_VT); const float* BK = WSP(float, WS_BK); bf16* AO = WSP(bf16, WS_AO);
    LAS float* wl = (LAS float*)C.lds + C.wave * 64;
    const int c32 = C.lane & 31, hi = C.lane >> 5;
    constexpr float C2 = 1.4426950408889634f * ATT_SCALE;
    const int gw = blockIdx.x * NWAVES + C.wave, NGW = C.G * NWAVES;
    for (int u = gw; u < NH * 256; u += NGW) {
        const int h = u & 15, idx = u >> 4, half = idx >> 7, qb = half ? (idx & 127) : 255 - (idx & 127);
        const int q0 = 32 * qb;
        const bf16* Qp = QH + ((size_t)h * S + q0 + c32) * HD + 8 * hi;
        bf16x8 qf[8];
#pragma unroll
        for (int d0 = 0; d0 < 8; ++d0) qf[d0] = *(const bf16x8*)(Qp + 16 * d0);
        f32x16 o[4];
#pragma unroll
        for (int d = 0; d < 4; ++d)
#pragma unroll
            for (int r = 0; r < 16; ++r) o[d][r] = 0.f;
        float m_run = -1e30f, l_run = 0.f;
        for (int jt = 0; jt <= qb; ++jt) {
            const int k0 = 32 * jt;
            f32x16 p;
#pragma unroll
            for (int r = 0; r < 16; ++r) p[r] = 0.f;
            const bf16* Kp = KH + ((size_t)h * S + k0 + c32) * HD + 8 * hi;
#pragma unroll
            for (int d0 = 0; d0 < 8; ++d0) { const bf16x8 kf = *(const bf16x8*)(Kp + 16 * d0); p = __builtin_amdgcn_mfma_f32_32x32x16_bf16(kf, qf[d0], p, 0, 0, 0); }
            float mx = -__builtin_inff();
#pragma unroll
            for (int r = 0; r < 16; ++r) { const int key = k0 + crow(r, hi); float sv = (p[r] + BK[(size_t)h * S + key]) * C2; if (key > q0 + c32) sv = -__builtin_inff(); p[r] = sv; mx = fmaxf(mx, sv); }
            mx = fmaxf(mx, __shfl_xor(mx, 32));
            const float m_new = fmaxf(m_run, mx), alpha = exp2f(m_run - m_new); m_run = m_new;
            float ps = 0.f;
#pragma unroll
            for (int r = 0; r < 16; ++r) { p[r] = exp2f(p[r] - m_new); ps += p[r]; }
            ps += __shfl_xor(ps, 32);
            l_run = l_run * alpha + ps;
            if (hi == 0) wl[c32] = alpha;
            LDS_WAIT(); asm volatile("" ::: "memory");
#pragma unroll
            for (int r = 0; r < 16; ++r) { const float a = wl[crow(r, hi)];
#pragma unroll
                for (int d = 0; d < 4; ++d) o[d][r] *= a; }
            LDS_WAIT(); asm volatile("" ::: "memory");
            bf16x8 pa[2];
#pragma unroll
            for (int ks = 0; ks < 2; ++ks) { u32x4 w; w.x = cvt_pk_bf16(p[8 * ks + 0], p[8 * ks + 1]); w.y = cvt_pk_bf16(p[8 * ks + 2], p[8 * ks + 3]); w.z = cvt_pk_bf16(p[8 * ks + 4], p[8 * ks + 5]); w.w = cvt_pk_bf16(p[8 * ks + 6], p[8 * ks + 7]); pa[ks] = *reinterpret_cast<bf16x8*>(&w); }
#pragma unroll
            for (int d = 0; d < 4; ++d) { const bf16* vp = VT + ((size_t)h * HD + 32 * d + c32) * S + k0 + 4 * hi;
#pragma unroll
                for (int ks = 0; ks < 2; ++ks) { const s16x4 v0 = *(const s16x4*)(vp + 16 * ks), v1 = *(const s16x4*)(vp + 16 * ks + 8);
                    const bf16x8 vb = {v0[0], v0[1], v0[2], v0[3], v1[0], v1[1], v1[2], v1[3]};
                    o[d] = __builtin_amdgcn_mfma_f32_32x32x16_bf16(pa[ks], vb, o[d], 0, 0, 0); } }
        }
        if (hi == 0) wl[c32] = 1.0f / l_run;
        LDS_WAIT(); asm volatile("" ::: "memory");
#pragma unroll
        for (int r = 0; r < 16; ++r) { const int qr = crow(r, hi); const float il = wl[qr];
#pragma unroll
            for (int d = 0; d < 4; ++d) AO[(size_t)(q0 + qr) * FW + h * HD + 32 * d + c32] = f2bf(o[d][r] * il); }
        LDS_WAIT(); asm volatile("" ::: "memory");
    }
}

struct EZs { bf16 *QH, *VT, *PP, *GA, *GP;
    __device__ __forceinline__ void operator()(int row, int col, float v) const {
        if (col < 6144) { const int part = col >> 11, h = (col & 2047) >> 7, d = col & 127; bf16* dst = QH + (size_t)part * (16u << 20); const bf16 b = f2bf(v);
            dst[((size_t)h * S + row) * HD + d] = b; if (part == 2) VT[((size_t)h * HD + d) * S + row] = b; }
        else if (col < 8192) PP[(size_t)row * PW + (col - 6144)] = f2bf(v);
        else if (col < 12288) GA[(size_t)row * D + (col - 8192)] = f2bf(sigmoidf_(v));
        else GP[(size_t)row * D + (col - 12288)] = f2bf(sigmoidf_(v)); } };
struct ETs { const bf16* GP; float* T;
    __device__ __forceinline__ void operator()(int row, int col, float v) const { T[(size_t)row * D + col] = bf2f(GP[(size_t)row * D + col]) * v; } };
struct EMs { const bf16* GA; const float* T; bf16* MX;
    __device__ __forceinline__ void operator()(int row, int col, float v) const { MX[(size_t)row * D + col] = f2bf(bf2f(GA[(size_t)row * D + col]) * v + T[(size_t)row * D + col]); } };
struct EYs { const float* base; const float* gate; float* Y;
    __device__ __forceinline__ void operator()(int row, int col, float v) const { Y[(size_t)row * D + col] = ALPHA * base[(size_t)row * D + col] + gate[col] * v; } };
struct EGUs { bf16* ACT;
    __device__ __forceinline__ void operator()(int row, int j, float g, float up) const { ACT[(size_t)row * FFN + j] = f2bf(g / (1.0f + __expf(-g)) * up); } };

struct Args { const float* in[16]; float* out; unsigned char* ws; int ph_lo, ph_hi; };
constexpr int N_PHASES = 12;

__global__ void __launch_bounds__(NTHREADS, 2) fwd_kernel(Args args) {
    extern __shared__ __attribute__((aligned(16))) unsigned char lds[];
    Ctx C;
    C.lds = (LAS unsigned char*)lds; C.tid = threadIdx.x; C.lane = C.tid & 63; C.wave = __builtin_amdgcn_readfirstlane(C.tid >> 6); C.G = gridDim.x;
    C.x = args.in[0]; C.c = args.in[1]; C.w_ada = args.in[2]; C.b_ada = args.in[3]; C.w_in = args.in[4]; C.b_forget = args.in[5]; C.w_attn_out = args.in[6]; C.w_pool = args.in[7];
    C.pool_scale = args.in[8]; C.w_out = args.in[9]; C.ln1_g = args.in[10]; C.ln1_b = args.in[11]; C.w_gate_up = args.in[12]; C.w_down = args.in[13]; C.ln2_g = args.in[14]; C.ln2_b = args.in[15];
    C.out = args.out; C.ws = args.ws;
    const int lo = args.ph_lo, hi = args.ph_hi;
#define IN(k) (lo <= (k) && (k) < hi)
    if (IN(0)) ph_prologue(C);
    if (IN(1)) ph_ln1(C);
    if (IN(2)) { ph_flogit(C);
        EZs E{WSP(bf16, WS_QH), WSP(bf16, WS_VT), WSP(bf16, WS_PP), WSP(bf16, WS_GA), WSP(bf16, WS_GP)};
        sgemm_phase<false>(C, WSP(bf16, WS_U), D, WSP(bf16, WS_WZ), D, S, NZ, D, 1 << 30, 0, E); }
    if (IN(3)) ph_scan_pool(C);
    if (IN(4)) ph_attn_simple(C);
    if (IN(5)) { ETs E{WSP(bf16, WS_GP), WSP(float, WS_T)}; sgemm_phase<false>(C, WSP(bf16, WS_PL), PW, WSP(bf16, WS_WP), 512, S, D, 512, 1024, 512, E); }
    if (IN(6)) { EMs E{WSP(bf16, WS_GA), WSP(float, WS_T), WSP(bf16, WS_MX)}; sgemm_phase<false>(C, WSP(bf16, WS_AO), FW, WSP(bf16, WS_WA), FW, S, D, FW, 1 << 30, 0, E); }
    if (IN(7)) { EYs E{C.x, WSP(float, WS_MOD) + 2 * D, WSP(float, WS_Y)}; sgemm_phase<false>(C, WSP(bf16, WS_MX), D, WSP(bf16, WS_WO), D, S, D, D, 1 << 30, 0, E); }
    if (IN(8)) ph_ln_mid(C);
    if (IN(9)) { EGUs E{WSP(bf16, WS_ACT)}; sgemm_phase<true>(C, WSP(bf16, WS_U), D, WSP(bf16, WS_WGU), D, S, NGU, D, 1 << 30, 0, E); }
    if (IN(10)) { EYs E{WSP(float, WS_X1), WSP(float, WS_MOD) + 5 * D, WSP(float, WS_Y)}; sgemm_phase<false>(C, WSP(bf16, WS_ACT), FFN, WSP(bf16, WS_WD), FFN, S, D, FFN, 1 << 30, 0, E); }
    if (IN(11)) ph_ln_final(C);
#undef IN
}

extern "C" void kernel_launch(void* const* d_in, const int* in_sizes, int n_in, void* d_out, int out_size, void* d_ws, size_t ws_size, hipStream_t stream) {
    static int grid = 0;
    if (grid == 0) {
        if (n_in != 16 || in_sizes[0] != S * D || out_size != S * D || ws_size < WS_END) { fprintf(stderr, "kernel_launch: unexpected shapes (n_in %d, in0 %d, out %d, ws %zu < %zu)\n", n_in, n_in > 0 ? in_sizes[0] : -1, out_size, ws_size, (size_t)WS_END); grid = -1; return; }
        int dev = 0, cus = 0;
        if (hipGetDevice(&dev) != hipSuccess || hipDeviceGetAttribute(&cus, hipDeviceAttributeMultiprocessorCount, dev) != hipSuccess || cus <= 0) cus = 256;
        if (hipFuncSetAttribute((const void*)fwd_kernel, hipFuncAttributeMaxDynamicSharedMemorySize, LDS_BYTES) != hipSuccess) { fprintf(stderr, "kernel_launch: hipFuncSetAttribute failed\n"); grid = -1; return; }
        grid = cus;
    }
    if (grid < 0) return;
    Args a{};
    for (int i = 0; i < 16; ++i) a.in[i] = (const float*)d_in[i];
    a.out = (float*)d_out; a.ws = (unsigned char*)d_ws;
    for (int ph = 0; ph < N_PHASES; ++ph) { a.ph_lo = ph; a.ph_hi = ph + 1; hipLaunchKernelGGL(fwd_kernel, dim3(grid), dim3(NTHREADS), LDS_BYTES, stream, a); }
}
```

```cpp
#include <hip/hip_runtime.h>
#include <cstdio>
#include <cstdint>

#define GAS __attribute__((address_space(1)))
#define LAS __attribute__((address_space(3)))
typedef unsigned short bf16;
typedef short bf16x8 __attribute__((ext_vector_type(8)));
typedef short s16x4 __attribute__((ext_vector_type(4)));
typedef float f32x4 __attribute__((ext_vector_type(4)));
typedef float f32x16 __attribute__((ext_vector_type(16)));
typedef unsigned u32x4 __attribute__((ext_vector_type(4)));
typedef unsigned u32x2 __attribute__((ext_vector_type(2)));

constexpr int S = 8192, D = 4096, NH = 16, HD = 128, FW = 2048, PW = 2048, FFN = 11008, INC = 16400, D6 = 6 * D;
constexpr int NZ = 16384;
constexpr int NGU = 2 * FFN;
constexpr float LN_EPS = 1e-5f;
constexpr float ALPHA = 1.189207115002721f;
constexpr float ATT_SCALE = 0.08838834764831845f;
constexpr float INV_ATT_SCALE = 11.313708498984761f;
constexpr int NWAVES = 8, NTHREADS = 512;

constexpr size_t MiB = 1u << 20;
constexpr size_t WS_CTL = 0;
constexpr size_t WS_MODP = 1 * MiB;
constexpr size_t WS_MOD = 2 * MiB;
constexpr size_t WS_FL = 3 * MiB;
constexpr size_t WS_BK = 4 * MiB;
constexpr size_t WS_WF = 5 * MiB;
constexpr size_t WS_WZ = 8 * MiB;
constexpr size_t WS_WA = WS_WZ + 128 * MiB;
constexpr size_t WS_WP = WS_WA + 16 * MiB;
constexpr size_t WS_WO = WS_WP + 4 * MiB;
constexpr size_t WS_WGU = WS_WO + 32 * MiB;
constexpr size_t WS_WD = WS_WGU + 172 * MiB;
constexpr size_t WS_U = WS_WD + 86 * MiB;
constexpr size_t WS_QH = WS_U + 64 * MiB;
constexpr size_t WS_KH = WS_QH + 32 * MiB;
constexpr size_t WS_VH = WS_KH + 32 * MiB;
constexpr size_t WS_VT = WS_VH + 32 * MiB;
constexpr size_t WS_PP = WS_VT + 32 * MiB;
constexpr size_t WS_GA = WS_PP + 32 * MiB;
constexpr size_t WS_GP = WS_GA + 64 * MiB;
constexpr size_t WS_ACT = WS_QH;
constexpr size_t WS_PL = WS_GP + 64 * MiB;
constexpr size_t WS_AO = WS_PL + 32 * MiB;
constexpr size_t WS_T = WS_AO + 32 * MiB;
constexpr size_t WS_MX = WS_T + 128 * MiB;
constexpr size_t WS_Y = WS_MX + 64 * MiB;
constexpr size_t WS_X1 = WS_Y + 128 * MiB;
constexpr size_t WS_END = WS_X1 + 128 * MiB;
static_assert(WS_QH + 172 * MiB <= WS_GP && WS_KH == WS_QH + 32 * MiB && WS_VH == WS_KH + 32 * MiB, "ACT overlay / QKV contiguity");

constexpr int LDS_BYTES = 147456;
constexpr int MISC_OFF = 131072 + 320;
constexpr int CW_BAR = 4096;
constexpr size_t CTL_ZERO_BYTES = 1u << 20;

__device__ __forceinline__ unsigned cvt_pk_bf16(float lo, float hi) { unsigned r; asm volatile("v_cvt_pk_bf16_f32 %0, %1, %2" : "=v"(r) : "v"(lo), "v"(hi)); return r; }
__device__ __forceinline__ bf16 f2bf(float f) { return (bf16)(cvt_pk_bf16(f, 0.f) & 0xffffu); }
__device__ __forceinline__ float bf2f(bf16 b) { return __uint_as_float(((unsigned)b) << 16); }
__device__ __forceinline__ float wave_sum(float v) {
#pragma unroll
    for (int o = 1; o < 64; o <<= 1) v += __shfl_xor(v, o);
    return v;
}
__device__ __forceinline__ float sigmoidf_(float x) { return 1.0f / (1.0f + __expf(-x)); }
#define LDS_WAIT() asm volatile("s_waitcnt lgkmcnt(0)" ::: "memory")
#define VM_WAIT() asm volatile("s_waitcnt vmcnt(0)" ::: "memory")

struct Ctx {
    LAS unsigned char* lds;
    int tid, lane, wave, G;
    const float *x, *c, *w_ada, *b_ada, *w_in, *b_forget, *w_attn_out, *w_pool, *pool_scale, *w_out, *ln1_g, *ln1_b, *w_gate_up, *w_down, *ln2_g, *ln2_b;
    float* out;
    unsigned char* ws;
};
#define WSP(T, off) ((T*)(C.ws + (off)))

__device__ __forceinline__ void conv_item(const float* W, int ldw, int k0, int srcn0, bf16* dst, int ldd, int dstr0, const float* rscale, LAS float* scr, int lane) {
#pragma unroll 8
    for (int i = 0; i < 32; ++i) { const int kk = 2 * i + (lane >> 5); scr[kk * 33 + (lane & 31)] = W[(size_t)(k0 + kk) * ldw + srcn0 + (lane & 31)]; }
    LDS_WAIT(); asm volatile("" ::: "memory");
    const int c = lane & 7;
#pragma unroll
    for (int j = 0; j < 4; ++j) { const int n = (lane >> 3) + 8 * j; const LAS float* s = scr + (8 * c) * 33 + n;
        const float sc = rscale ? rscale[dstr0 + n] : 1.0f;
        u32x4 o; o.x = cvt_pk_bf16(s[0 * 33] * sc, s[1 * 33] * sc); o.y = cvt_pk_bf16(s[2 * 33] * sc, s[3 * 33] * sc); o.z = cvt_pk_bf16(s[4 * 33] * sc, s[5 * 33] * sc); o.w = cvt_pk_bf16(s[6 * 33] * sc, s[7 * 33] * sc);
        *(u32x4*)(dst + (size_t)(dstr0 + n) * ldd + k0 + 8 * c) = o; }
    LDS_WAIT(); asm volatile("" ::: "memory");
}

__device__ __forceinline__ void ph_prologue(Ctx& C) {
    {
        LAS float* sl = (LAS float*)C.lds;
        LAS float* red = sl + 512;
        float* modp = WSP(float, WS_MODP);
        for (int task = blockIdx.x; task < 256; task += C.G) {
            const int kg = task >> 5, cs = task & 31;
            { const float cv = C.c[512 * kg + C.tid]; sl[C.tid] = cv / (1.0f + __expf(-cv)); }
            __syncthreads();
            f32x4 acc[3] = {};
            const f32x4* wrow = (const f32x4*)(C.w_ada + (size_t)(512 * kg + 64 * C.wave) * D6) + cs * 192 + C.lane;
#pragma unroll 4
            for (int r = 0; r < 64; ++r) { const float s = sl[64 * C.wave + r];
#pragma unroll
                for (int q = 0; q < 3; ++q) { const f32x4 v = wrow[(size_t)r * (D6 / 4) + 64 * q]; acc[q] += v * s; } }
#pragma unroll
            for (int q = 0; q < 3; ++q) *(LAS f32x4*)(red + C.wave * 768 + (C.lane + 64 * q) * 4) = acc[q];
            __syncthreads();
            if (C.tid < 192) { f32x4 s = {0.f, 0.f, 0.f, 0.f};
#pragma unroll
                for (int w = 0; w < 8; ++w) s += *(LAS f32x4*)(red + w * 768 + C.tid * 4);
                *(f32x4*)(modp + (size_t)kg * D6 + cs * 768 + C.tid * 4) = s; }
            __syncthreads();
        }
    }
    {
        LAS float* scr = (LAS float*)(C.lds + C.wave * 16384);
        const int gw = blockIdx.x * NWAVES + C.wave, NGW = C.G * NWAVES;
        constexpr int I_ZA = 64 * 192, I_ZB = 64 * 320, I_A = 32 * 128, I_P = 4 * 8 * 32, I_O = 64 * 128, I_GU = 64 * 688, I_D = 172 * 128;
        constexpr int NITEMS = I_ZA + I_ZB + I_A + I_P + I_O + I_GU + I_D;
        for (int it = gw; it < NITEMS; it += NGW) {
            int r = it;
            if (r < I_GU) { const int kb = r / 688, nb = r % 688, r0 = 32 * nb, tile = r0 >> 8, within = r0 & 255, half = within >> 7, j0 = tile * 128 + (within & 127);
                conv_item(C.w_gate_up, NGU, 64 * kb, half * FFN + j0, WSP(bf16, WS_WGU), D, r0, nullptr, scr, C.lane); continue; } r -= I_GU;
            if (r < I_D) { const int kb = r / 128, nb = r % 128; conv_item(C.w_down, D, 64 * kb, 32 * nb, WSP(bf16, WS_WD), FFN, 32 * nb, nullptr, scr, C.lane); continue; } r -= I_D;
            if (r < I_O) { const int kb = r / 128, nb = r % 128; conv_item(C.w_out, D, 64 * kb, 32 * nb, WSP(bf16, WS_WO), D, 32 * nb, nullptr, scr, C.lane); continue; } r -= I_O;
            if (r < I_A) { const int kb = r / 128, nb = r % 128; conv_item(C.w_attn_out, D, 64 * kb, 32 * nb, WSP(bf16, WS_WA), FW, 32 * nb, nullptr, scr, C.lane); continue; } r -= I_A;
            if (r < I_P) { const int g = r / 256, rr = r % 256, kb = rr / 32, nb = rr % 32;
                conv_item(C.w_pool + (size_t)g * 512 * 1024, 1024, 64 * kb, 32 * nb, WSP(bf16, WS_WP), 512, 1024 * g + 32 * nb, C.pool_scale, scr, C.lane); continue; } r -= I_P;
            if (r < I_ZA) { const int kb = r / 192, nb = r % 192; conv_item(C.w_in, INC, 64 * kb, 32 * nb, WSP(bf16, WS_WZ), D, 32 * nb, nullptr, scr, C.lane); continue; } r -= I_ZA;
            { const int kb = r / 320, nb = r % 320; conv_item(C.w_in, INC, 64 * kb, 6160 + 32 * nb, WSP(bf16, WS_WZ), D, 6144 + 32 * nb, nullptr, scr, C.lane); }
        }
        bf16* wf = WSP(bf16, WS_WF);
        for (int g = blockIdx.x * NTHREADS + C.tid; g < 16 * D; g += C.G * NTHREADS) { const int h = g & 15, k = g >> 4; wf[h * D + k] = f2bf(C.w_in[(size_t)k * INC + 6144 + h]); }
    }
}

__device__ __forceinline__ void row_load(const float* rowp, int lane, f32x4 (&v)[16]) {
    const f32x4* p = (const f32x4*)rowp + lane;
#pragma unroll
    for (int j = 0; j < 16; ++j) v[j] = p[64 * j];
}
__device__ __forceinline__ void row_normalize(f32x4 (&v)[16]) {
    float s = 0.f;
#pragma unroll
    for (int j = 0; j < 16; ++j) s += (v[j].x + v[j].y) + (v[j].z + v[j].w);
    const float mean = wave_sum(s) * (1.0f / D); float s2 = 0.f;
#pragma unroll
    for (int j = 0; j < 16; ++j) { v[j] = v[j] - mean; s2 += (v[j].x * v[j].x + v[j].y * v[j].y) + (v[j].z * v[j].z + v[j].w * v[j].w); }
    const float rstd = 1.0f / sqrtf(wave_sum(s2) * (1.0f / D) + LN_EPS);
#pragma unroll
    for (int j = 0; j < 16; ++j) v[j] = v[j] * rstd;
}
__device__ __forceinline__ void mod_to_lds(Ctx& C, LAS float* dst, int chunk, float add) {
    const float* modp = WSP(float, WS_MODP);
    for (int c = C.tid; c < D; c += NTHREADS) { float s = C.b_ada[chunk * D + c];
#pragma unroll
        for (int kg = 0; kg < 8; ++kg) s += modp[(size_t)kg * D6 + chunk * D + c];
        dst[c] = s + add; }
}

__device__ __forceinline__ void ph_ln1(Ctx& C) {
    LAS float* sc = (LAS float*)C.lds; LAS float* sh = sc + D;
    mod_to_lds(C, sh, 0, 0.f); mod_to_lds(C, sc, 1, 1.f);
    { const float* modp = WSP(float, WS_MODP); float* mod = WSP(float, WS_MOD);
      for (int j = blockIdx.x * NTHREADS + C.tid; j < D6; j += C.G * NTHREADS) { float s = C.b_ada[j];
#pragma unroll
          for (int kg = 0; kg < 8; ++kg) s += modp[(size_t)kg * D6 + j];
          mod[j] = s; } }
    __syncthreads();
    bf16* U = WSP(bf16, WS_U);
    for (int row = blockIdx.x * NWAVES + C.wave; row < S; row += C.G * NWAVES) {
        f32x4 v[16]; row_load(C.x + (size_t)row * D, C.lane, v); row_normalize(v);
        u32x2* o = (u32x2*)(U + (size_t)row * D) + C.lane;
#pragma unroll
        for (int j = 0; j < 16; ++j) { const f32x4 a = *(LAS f32x4*)(sc + 4 * (C.lane + 64 * j)), b = *(LAS f32x4*)(sh + 4 * (C.lane + 64 * j)); const f32x4 r = v[j] * a + b;
            u32x2 w; w.x = cvt_pk_bf16(r.x, r.y); w.y = cvt_pk_bf16(r.z, r.w); o[64 * j] = w; }
    }
}
__device__ __forceinline__ void ph_ln_mid(Ctx& C) {
    LAS float* g = (LAS float*)C.lds; LAS float* b = g + D; LAS float* sc = b + D; LAS float* sh = sc + D;
    const float* mod = WSP(float, WS_MOD);
    for (int c = C.tid; c < D; c += NTHREADS) { g[c] = C.ln1_g[c]; b[c] = C.ln1_b[c]; sh[c] = mod[3 * D + c]; sc[c] = 1.0f + mod[4 * D + c]; }
    __syncthreads();
    bf16* U = WSP(bf16, WS_U); const float* Y = WSP(float, WS_Y); float* X1 = WSP(float, WS_X1);
    for (int row = blockIdx.x * NWAVES + C.wave; row < S; row += C.G * NWAVES) {
        f32x4 v[16]; row_load(Y + (size_t)row * D, C.lane, v); row_normalize(v);
        f32x4* xo = (f32x4*)(X1 + (size_t)row * D) + C.lane;
#pragma unroll
        for (int j = 0; j < 16; ++j) { const f32x4 a = *(LAS f32x4*)(g + 4 * (C.lane + 64 * j)), bb = *(LAS f32x4*)(b + 4 * (C.lane + 64 * j)); v[j] = v[j] * a + bb; xo[64 * j] = v[j]; }
        row_normalize(v);
        u32x2* o = (u32x2*)(U + (size_t)row * D) + C.lane;
#pragma unroll
        for (int j = 0; j < 16; ++j) { const f32x4 a = *(LAS f32x4*)(sc + 4 * (C.lane + 64 * j)), bb = *(LAS f32x4*)(sh + 4 * (C.lane + 64 * j)); const f32x4 r = v[j] * a + bb;
            u32x2 w; w.x = cvt_pk_bf16(r.x, r.y); w.y = cvt_pk_bf16(r.z, r.w); o[64 * j] = w; }
    }
}
__device__ __forceinline__ void ph_ln_final(Ctx& C) {
    LAS float* g = (LAS float*)C.lds; LAS float* b = g + D;
    for (int c = C.tid; c < D; c += NTHREADS) { g[c] = C.ln2_g[c]; b[c] = C.ln2_b[c]; }
    __syncthreads();
    const float* Y = WSP(float, WS_Y);
    for (int row = blockIdx.x * NWAVES + C.wave; row < S; row += C.G * NWAVES) {
        f32x4 v[16]; row_load(Y + (size_t)row * D, C.lane, v); row_normalize(v);
        f32x4* xo = (f32x4*)(C.out + (size_t)row * D) + C.lane;
#pragma unroll
        for (int j = 0; j < 16; ++j) { const f32x4 a = *(LAS f32x4*)(g + 4 * (C.lane + 64 * j)), bb = *(LAS f32x4*)(b + 4 * (C.lane + 64 * j)); xo[64 * j] = v[j] * a + bb; }
    }
}

__device__ __forceinline__ void ph_flogit(Ctx& C) {
    const bf16* U = WSP(bf16, WS_U); const bf16* WF = WSP(bf16, WS_WF); float* FL = WSP(float, WS_FL);
    LAS float* red = (LAS float*)C.lds;
    const int fr = C.lane & 15, fq = C.lane >> 4, rg = C.wave >> 2, kq = C.wave & 3;
    for (int blk = blockIdx.x; blk < S / 32; blk += C.G) {
        const int row = 32 * blk + 16 * rg + fr;
        const bf16* ap = U + (size_t)row * D + 1024 * kq + 8 * fq; const bf16* bp = WF + (size_t)fr * D + 1024 * kq + 8 * fq;
        f32x4 acc = {0.f, 0.f, 0.f, 0.f};
#pragma unroll 8
        for (int k = 0; k < 32; ++k) { const bf16x8 a = *(const bf16x8*)(ap + 32 * k), b = *(const bf16x8*)(bp + 32 * k); acc = __builtin_amdgcn_mfma_f32_16x16x32_bf16(a, b, acc, 0, 0, 0); }
        *(LAS f32x4*)(red + C.wave * 256 + C.lane * 4) = acc;
        __syncthreads();
        if (kq == 0) { f32x4 s = acc;
#pragma unroll
            for (int w = 1; w < 4; ++w) s += *(LAS f32x4*)(red + (C.wave + w) * 256 + C.lane * 4);
            s += C.b_forget[fr];
            *(f32x4*)(FL + (size_t)fr * S + 32 * blk + 16 * rg + 4 * fq) = s; }
        __syncthreads();
    }
}

__device__ __forceinline__ void ph_scan_pool(Ctx& C) {
    LAS float* wsum = (LAS float*)C.lds;
    for (int h = blockIdx.x; h < NH; h += C.G) {
        const float* fl = WSP(float, WS_FL) + (size_t)h * S; float* bk = WSP(float, WS_BK) + (size_t)h * S;
        float v[16];
#pragma unroll
        for (int q = 0; q < 4; ++q) { const f32x4 t = *(const f32x4*)(fl + 16 * C.tid + 4 * q); v[4 * q] = t.x; v[4 * q + 1] = t.y; v[4 * q + 2] = t.z; v[4 * q + 3] = t.w; }
        float run = 0.f;
#pragma unroll
        for (int i = 0; i < 16; ++i) { const float xx = v[i]; const float ls = -(fmaxf(-xx, 0.f) + log1pf(__expf(-fabsf(xx)))); run += ls; v[i] = run; }
        float incl = run;
#pragma unroll
        for (int o = 1; o < 64; o <<= 1) { const float t = __shfl_up(incl, o); if (C.lane >= o) incl += t; }
        if (C.lane == 63) wsum[C.wave] = incl;
        __syncthreads();
        float off = incl - run;
        for (int w = 0; w < C.wave; ++w) off += wsum[w];
#pragma unroll
        for (int q = 0; q < 4; ++q) { f32x4 t; t.x = -(v[4 * q] + off) * INV_ATT_SCALE; t.y = -(v[4 * q + 1] + off) * INV_ATT_SCALE; t.z = -(v[4 * q + 2] + off) * INV_ATT_SCALE; t.w = -(v[4 * q + 3] + off) * INV_ATT_SCALE;
            *(f32x4*)(bk + 16 * C.tid + 4 * q) = t; }
        __syncthreads();
    }
    const bf16* PP = WSP(bf16, WS_PP); bf16* PL = WSP(bf16, WS_PL);
    for (int gt = blockIdx.x * NTHREADS + C.tid; gt < (S / 16) * (PW / 8); gt += C.G * NTHREADS) {
        const int cc = gt & 255, rc = gt >> 8, g = cc >> 6, w = 2 << g, r0 = 16 * rc;
        const bf16* base = PP + 8 * cc; float sum[8] = {0.f, 0.f, 0.f, 0.f, 0.f, 0.f, 0.f, 0.f};
        for (int j = 1; j < w; ++j) { const int r = r0 - j; if (r >= 0) { const bf16x8 t = *(const bf16x8*)(base + (size_t)r * PW);
#pragma unroll
                for (int e = 0; e < 8; ++e) sum[e] += bf2f((bf16)t[e]); } }
        for (int i = 0; i < 16; ++i) { const int r = r0 + i; const bf16x8 t = *(const bf16x8*)(base + (size_t)r * PW);
            const float inv = 1.0f / (float)((r + 1) < w ? (r + 1) : w); float o[8];
#pragma unroll
            for (int e = 0; e < 8; ++e) { const float pv = bf2f((bf16)t[e]); sum[e] += pv; o[e] = sum[e] * inv - pv; }
            u32x4 ow; ow.x = cvt_pk_bf16(o[0], o[1]); ow.y = cvt_pk_bf16(o[2], o[3]); ow.z = cvt_pk_bf16(o[4], o[5]); ow.w = cvt_pk_bf16(o[6], o[7]);
            *(u32x4*)(PL + (size_t)r * PW + 8 * cc) = ow;
            const int ro = r - w + 1; if (ro >= 0) { const bf16x8 t2 = *(const bf16x8*)(base + (size_t)ro * PW);
#pragma unroll
                for (int e = 0; e < 8; ++e) sum[e] -= bf2f((bf16)t2[e]); } }
    }
}

template <bool PAIR, class Epi>
__device__ __forceinline__ void sgemm_phase(Ctx& C, const bf16* A, int lda, const bf16* Bt, int ldb, int M, int N, int K, int grp_cols, int grp_off, const Epi& E) {
    const int fr = C.lane & 15, fq = C.lane >> 4, wm = C.wave >> 2, wn = C.wave & 3;
    const int nTn = N / 256, nT = (M / 128) * nTn;
    for (int t = blockIdx.x; t < nT; t += C.G) {
        const int tm = t / nTn, tn = t % nTn, row0 = tm * 128 + wm * 64;
        const bf16* Ab = A + (size_t)((tn * 256) / grp_cols) * grp_off;
        int brow[4];
#pragma unroll
        for (int j = 0; j < 4; ++j) brow[j] = PAIR ? (tn * 256 + (j >> 1) * 128 + wn * 32 + (j & 1) * 16 + fr) : (tn * 256 + wn * 64 + 16 * j + fr);
        f32x4 acc[4][4];
#pragma unroll
        for (int i = 0; i < 4; ++i)
#pragma unroll
            for (int j = 0; j < 4; ++j) acc[i][j] = (f32x4){0.f, 0.f, 0.f, 0.f};
        for (int k0 = 0; k0 < K; k0 += 32) {
            bf16x8 a[4], b[4];
#pragma unroll
            for (int i = 0; i < 4; ++i) a[i] = *(const bf16x8*)(Ab + (size_t)(row0 + 16 * i + fr) * lda + k0 + 8 * fq);
#pragma unroll
            for (int j = 0; j < 4; ++j) b[j] = *(const bf16x8*)(Bt + (size_t)brow[j] * ldb + k0 + 8 * fq);
#pragma unroll
            for (int i = 0; i < 4; ++i)
#pragma unroll
                for (int j = 0; j < 4; ++j) acc[i][j] = __builtin_amdgcn_mfma_f32_16x16x32_bf16(a[i], b[j], acc[i][j], 0, 0, 0);
        }
        if constexpr (PAIR) {
#pragma unroll
            for (int i = 0; i < 4; ++i)
#pragma unroll
                for (int j = 0; j < 2; ++j)
#pragma unroll
                    for (int e = 0; e < 4; ++e) E(row0 + 16 * i + 4 * fq + e, tn * 128 + wn * 32 + j * 16 + fr, acc[i][j][e], acc[i][j + 2][e]);
        } else {
#pragma unroll
            for (int i = 0; i < 4; ++i)
#pragma unroll
                for (int j = 0; j < 4; ++j)
#pragma unroll
                    for (int e = 0; e < 4; ++e) E(row0 + 16 * i + 4 * fq + e, tn * 256 + wn * 64 + 16 * j + fr, acc[i][j][e]);
        }
    }
}

__device__ __forceinline__ int crow(int r, int hi) { return (r & 3) + 8 * (r >> 2) + 4 * hi; }
__device__ __forceinline__ void ph_attn_simple(Ctx& C) {
    const bf16* QH = WSP(bf16, WS_QH); const bf16* KH = WSP(bf16, WS_KH); const bf16* VT = WSP(bf16, WS_VT); const float* BK = WSP(float, WS_BK); bf16* AO = WSP(bf16, WS_AO);
    LAS float* wl = (LAS float*)C.lds + C.wave * 64;
    const int c32 = C.lane & 31, hi = C.lane >> 5;
    constexpr float C2 = 1.4426950408889634f * ATT_SCALE;
    const int gw = blockIdx.x * NWAVES + C.wave, NGW = C.G * NWAVES;
    for (int u = gw; u < NH * 256; u += NGW) {
        const int h = u & 15, idx = u >> 4, half = idx >> 7, qb = half ? (idx & 127) : 255 - (idx & 127);
        const int q0 = 32 * qb;
        const bf16* Qp = QH + ((size_t)h * S + q0 + c32) * HD + 8 * hi;
        bf16x8 qf[8];
#pragma unroll
        for (int d0 = 0; d0 < 8; ++d0) qf[d0] = *(const bf16x8*)(Qp + 16 * d0);
        f32x16 o[4];
#pragma unroll
        for (int d = 0; d < 4; ++d)
#pragma unroll
            for (int r = 0; r < 16; ++r) o[d][r] = 0.f;
        float m_run = -1e30f, l_run = 0.f;
        for (int jt = 0; jt <= qb; ++jt) {
            const int k0 = 32 * jt;
            f32x16 p;
#pragma unroll
            for (int r = 0; r < 16; ++r) p[r] = 0.f;
            const bf16* Kp = KH + ((size_t)h * S + k0 + c32) * HD + 8 * hi;
#pragma unroll
            for (int d0 = 0; d0 < 8; ++d0) { const bf16x8 kf = *(const bf16x8*)(Kp + 16 * d0); p = __builtin_amdgcn_mfma_f32_32x32x16_bf16(kf, qf[d0], p, 0, 0, 0); }
            float mx = -__builtin_inff();
#pragma unroll
            for (int r = 0; r < 16; ++r) { const int key = k0 + crow(r, hi); float sv = (p[r] + BK[(size_t)h * S + key]) * C2; if (key > q0 + c32) sv = -__builtin_inff(); p[r] = sv; mx = fmaxf(mx, sv); }
            mx = fmaxf(mx, __shfl_xor(mx, 32));
            const float m_new = fmaxf(m_run, mx), alpha = exp2f(m_run - m_new); m_run = m_new;
            float ps = 0.f;
#pragma unroll
            for (int r = 0; r < 16; ++r) { p[r] = exp2f(p[r] - m_new); ps += p[r]; }
            ps += __shfl_xor(ps, 32);
            l_run = l_run * alpha + ps;
            if (hi == 0) wl[c32] = alpha;
            LDS_WAIT(); asm volatile("" ::: "memory");
#pragma unroll
            for (int r = 0; r < 16; ++r) { const float a = wl[crow(r, hi)];
#pragma unroll
                for (int d = 0; d < 4; ++d) o[d][r] *= a; }
            LDS_WAIT(); asm volatile("" ::: "memory");
            bf16x8 pa[2];
#pragma unroll
            for (int ks = 0; ks < 2; ++ks) { u32x4 w; w.x = cvt_pk_bf16(p[8 * ks + 0], p[8 * ks + 1]); w.y = cvt_pk_bf16(p[8 * ks + 2], p[8 * ks + 3]); w.z = cvt_pk_bf16(p[8 * ks + 4], p[8 * ks + 5]); w.w = cvt_pk_bf16(p[8 * ks + 6], p[8 * ks + 7]); pa[ks] = *reinterpret_cast<bf16x8*>(&w); }
#pragma unroll
            for (int d = 0; d < 4; ++d) { const bf16* vp = VT + ((size_t)h * HD + 32 * d + c32) * S + k0 + 4 * hi;
#pragma unroll
                for (int ks = 0; ks < 2; ++ks) { const s16x4 v0 = *(const s16x4*)(vp + 16 * ks), v1 = *(const s16x4*)(vp + 16 * ks + 8);
                    const bf16x8 vb = {v0[0], v0[1], v0[2], v0[3], v1[0], v1[1], v1[2], v1[3]};
                    o[d] = __builtin_amdgcn_mfma_f32_32x32x16_bf16(pa[ks], vb, o[d], 0, 0, 0); } }
        }
        if (hi == 0) wl[c32] = 1.0f / l_run;
        LDS_WAIT(); asm volatile("" ::: "memory");
#pragma unroll
        for (int r = 0; r < 16; ++r) { const int qr = crow(r, hi); const float il = wl[qr];
#pragma unroll
            for (int d = 0; d < 4; ++d) AO[(size_t)(q0 + qr) * FW + h * HD + 32 * d + c32] = f2bf(o[d][r] * il); }
        LDS_WAIT(); asm volatile("" ::: "memory");
    }
}

struct EZs { bf16 *QH, *VT, *PP, *GA, *GP;
    __device__ __forceinline__ void operator()(int row, int col, float v) const {
        if (col < 6144) { const int part = col >> 11, h = (col & 2047) >> 7, d = col & 127; bf16* dst = QH + (size_t)part * (16u << 20); const bf16 b = f2bf(v);
            dst[((size_t)h * S + row) * HD + d] = b; if (part == 2) VT[((size_t)h * HD + d) * S + row] = b; }
        else if (col < 8192) PP[(size_t)row * PW + (col - 6144)] = f2bf(v);
        else if (col < 12288) GA[(size_t)row * D + (col - 8192)] = f2bf(sigmoidf_(v));
        else GP[(size_t)row * D + (col - 12288)] = f2bf(sigmoidf_(v)); } };
struct ETs { const bf16* GP; float* T;
    __device__ __forceinline__ void operator()(int row, int col, float v) const { T[(size_t)row * D + col] = bf2f(GP[(size_t)row * D + col]) * v; } };
struct EMs { const bf16* GA; const float* T; bf16* MX;
    __device__ __forceinline__ void operator()(int row, int col, float v) const { MX[(size_t)row * D + col] = f2bf(bf2f(GA[(size_t)row * D + col]) * v + T[(size_t)row * D + col]); } };
struct EYs { const float* base; const float* gate; float* Y;
    __device__ __forceinline__ void operator()(int row, int col, float v) const { Y[(size_t)row * D + col] = ALPHA * base[(size_t)row * D + col] + gate[col] * v; } };
struct EGUs { bf16* ACT;
    __device__ __forceinline__ void operator()(int row, int j, float g, float up) const { ACT[(size_t)row * FFN + j] = f2bf(g / (1.0f + __expf(-g)) * up); } };

typedef GAS unsigned gu32;
#define RLX_AGENT __ATOMIC_RELAXED, __HIP_MEMORY_SCOPE_AGENT
#define XB_TMO      128
#define XB_XCNT(j)  (256  + 64 * (j))
#define XB_XSUB(j)  (1280 + 64 * (j))
#define XB_XGEN(j)  (2304 + 64 * (j))
#define XB_TOP      3328
#define XB_TOPGEN   3392
#define XCD_BAR_WORDS 3456
#define XB_SPIN_CAP (1u << 18)

__device__ __forceinline__ unsigned xb_ld(unsigned* p)              { return __hip_atomic_load(p, __ATOMIC_RELAXED, __HIP_MEMORY_SCOPE_AGENT); }
__device__ __forceinline__ unsigned xb_add(unsigned* p, unsigned v) { return __hip_atomic_fetch_add(p, v, __ATOMIC_RELAXED, __HIP_MEMORY_SCOPE_AGENT); }
__device__ __forceinline__ unsigned xb_xcc_id() { return (unsigned)__builtin_amdgcn_s_getreg((3 << 11) | 20) & 0xFu; }
#define XB_SPIN(cond, bar) do { unsigned _sp = 0; while (cond) { __builtin_amdgcn_s_sleep(1); \
    if ((++_sp & 255u) == 0u) { if (xb_ld(&(bar)[XB_TMO])) break; if (_sp > XB_SPIN_CAP) { atomicAdd(&(bar)[XB_TMO], 1u); break; } } } } while (0)

struct XcdBarrier {
    unsigned* bar; unsigned x;
    volatile LAS unsigned* st;
};

__device__ __forceinline__ XcdBarrier xcd_barrier_post(unsigned* bar, volatile LAS unsigned* st) {
    XcdBarrier b; b.bar = bar; b.x = xb_xcc_id(); b.st = st;
    if (threadIdx.x == 0) (void)xb_add(&bar[XB_XCNT(b.x)], 1u);
    return b;
}
__device__ __forceinline__ void xcd_barrier_complete(unsigned* bar, unsigned x, unsigned& nloc, unsigned& nx) {
    const unsigned G = gridDim.x * gridDim.y * gridDim.z;
    unsigned sum, cnt, mine, sp = 0u;
    for (;;) {
        sum = 0u; cnt = 0u; mine = 0u;
#pragma unroll
        for (unsigned j = 0; j < 16; ++j) { const unsigned c = xb_ld(&bar[XB_XCNT(j)]); sum += c; cnt += (c > 0u) ? 1u : 0u; mine = (j == x) ? c : mine; }
        if (sum == G) break;
        __builtin_amdgcn_s_sleep(1);
        if ((++sp & 255u) == 0u) { if (xb_ld(&bar[XB_TMO])) break; if (sp > XB_SPIN_CAP) { atomicAdd(&bar[XB_TMO], 1u); break; } }
    }
    nloc = mine > 0u ? mine : 1u; nx = cnt > 0u ? cnt : 1u;
}

__device__ __forceinline__ void xcd_barrier(const XcdBarrier& b) {
    asm volatile("s_waitcnt vmcnt(0)" ::: "memory");
    __syncthreads();
    if (threadIdx.x == 0) {
        unsigned* bar = b.bar;
        __builtin_amdgcn_s_waitcnt(0);
        unsigned nloc = b.st[0], nx = b.st[1];
        if (nloc == 0u) { xcd_barrier_complete(bar, b.x, nloc, nx); b.st[0] = nloc; b.st[1] = nx; }
        const unsigned old = xb_add(&bar[XB_XSUB(b.x)], 1u);
        const unsigned gen = old / nloc;
        if (old + 1u == (gen + 1u) * nloc) {
            __builtin_amdgcn_fence(__ATOMIC_RELEASE, "agent");
            asm volatile("s_waitcnt vmcnt(0)" ::: "memory");
            const unsigned og = xb_add(&bar[XB_TOP], 1u);
            const unsigned tg = og / nx;
            if (og + 1u == (tg + 1u) * nx) xb_add(&bar[XB_TOPGEN], 1u);
            else XB_SPIN(xb_ld(&bar[XB_TOPGEN]) == tg, bar);
            __builtin_amdgcn_fence(__ATOMIC_ACQUIRE, "agent");
            xb_add(&bar[XB_XGEN(b.x)], 1u);
            asm volatile("s_waitcnt vmcnt(0)" ::: "memory");
        } else {
            XB_SPIN(xb_ld(&bar[XB_XGEN(b.x)]) == gen, bar);
            __builtin_amdgcn_fence(__ATOMIC_ACQUIRE, "agent");
            asm volatile("s_waitcnt vmcnt(0)" ::: "memory");
        }
    }
    __syncthreads();
}


struct Args { const float* in[16]; float* out; unsigned char* ws; int ph_lo, ph_hi; };
constexpr int N_PHASES = 12;

__global__ void __launch_bounds__(NTHREADS, 2) fwd_kernel(Args args) {
    extern __shared__ __attribute__((aligned(16))) unsigned char lds[];
    Ctx C;
    C.lds = (LAS unsigned char*)lds; C.tid = threadIdx.x; C.lane = C.tid & 63; C.wave = __builtin_amdgcn_readfirstlane(C.tid >> 6); C.G = gridDim.x;
    C.x = args.in[0]; C.c = args.in[1]; C.w_ada = args.in[2]; C.b_ada = args.in[3]; C.w_in = args.in[4]; C.b_forget = args.in[5]; C.w_attn_out = args.in[6]; C.w_pool = args.in[7];
    C.pool_scale = args.in[8]; C.w_out = args.in[9]; C.ln1_g = args.in[10]; C.ln1_b = args.in[11]; C.w_gate_up = args.in[12]; C.w_down = args.in[13]; C.ln2_g = args.in[14]; C.ln2_b = args.in[15];
    C.out = args.out; C.ws = args.ws;
    const int lo = args.ph_lo, hi = args.ph_hi;
    volatile LAS unsigned* MISC = (volatile LAS unsigned*)(C.lds + MISC_OFF);
    for (int u = C.tid; u < 32; u += NTHREADS) MISC[u] = 0u;
    __syncthreads();
    XcdBarrier bar = xcd_barrier_post((unsigned*)(C.ws + WS_CTL) + CW_BAR, MISC + 8);
#define IN(k) (lo <= (k) && (k) < hi)
#define SEAM(k) do { if (IN(k) && IN((k) + 1)) xcd_barrier(bar); } while (0)
    if (IN(0)) ph_prologue(C);
    SEAM(0);
    if (IN(1)) ph_ln1(C);
    SEAM(1);
    if (IN(2)) { ph_flogit(C);
        EZs E{WSP(bf16, WS_QH), WSP(bf16, WS_VT), WSP(bf16, WS_PP), WSP(bf16, WS_GA), WSP(bf16, WS_GP)};
        sgemm_phase<false>(C, WSP(bf16, WS_U), D, WSP(bf16, WS_WZ), D, S, NZ, D, 1 << 30, 0, E); }
    SEAM(2);
    if (IN(3)) ph_scan_pool(C);
    SEAM(3);
    if (IN(4)) ph_attn_simple(C);
    SEAM(4);
    if (IN(5)) { ETs E{WSP(bf16, WS_GP), WSP(float, WS_T)}; sgemm_phase<false>(C, WSP(bf16, WS_PL), PW, WSP(bf16, WS_WP), 512, S, D, 512, 1024, 512, E); }
    SEAM(5);
    if (IN(6)) { EMs E{WSP(bf16, WS_GA), WSP(float, WS_T), WSP(bf16, WS_MX)}; sgemm_phase<false>(C, WSP(bf16, WS_AO), FW, WSP(bf16, WS_WA), FW, S, D, FW, 1 << 30, 0, E); }
    SEAM(6);
    if (IN(7)) { EYs E{C.x, WSP(float, WS_MOD) + 2 * D, WSP(float, WS_Y)}; sgemm_phase<false>(C, WSP(bf16, WS_MX), D, WSP(bf16, WS_WO), D, S, D, D, 1 << 30, 0, E); }
    SEAM(7);
    if (IN(8)) ph_ln_mid(C);
    SEAM(8);
    if (IN(9)) { EGUs E{WSP(bf16, WS_ACT)}; sgemm_phase<true>(C, WSP(bf16, WS_U), D, WSP(bf16, WS_WGU), D, S, NGU, D, 1 << 30, 0, E); }
    SEAM(9);
    if (IN(10)) { EYs E{WSP(float, WS_X1), WSP(float, WS_MOD) + 5 * D, WSP(float, WS_Y)}; sgemm_phase<false>(C, WSP(bf16, WS_ACT), FFN, WSP(bf16, WS_WD), FFN, S, D, FFN, 1 << 30, 0, E); }
    SEAM(10);
    if (IN(11)) ph_ln_final(C);
#undef SEAM
#undef IN
}

extern "C" void kernel_launch(void* const* d_in, const int* in_sizes, int n_in, void* d_out, int out_size, void* d_ws, size_t ws_size, hipStream_t stream) {
    static int grid = 0;
    if (grid == 0) {
        if (n_in != 16 || in_sizes[0] != S * D || out_size != S * D || ws_size < WS_END) { fprintf(stderr, "kernel_launch: unexpected shapes (n_in %d, in0 %d, out %d, ws %zu < %zu)\n", n_in, n_in > 0 ? in_sizes[0] : -1, out_size, ws_size, (size_t)WS_END); grid = -1; return; }
        int dev = 0, cus = 0;
        if (hipGetDevice(&dev) != hipSuccess || hipDeviceGetAttribute(&cus, hipDeviceAttributeMultiprocessorCount, dev) != hipSuccess || cus <= 0) cus = 256;
        if (hipFuncSetAttribute((const void*)fwd_kernel, hipFuncAttributeMaxDynamicSharedMemorySize, LDS_BYTES) != hipSuccess) { fprintf(stderr, "kernel_launch: hipFuncSetAttribute failed\n"); grid = -1; return; }
        grid = cus;
    }
    if (grid < 0) return;
    Args a{};
    for (int i = 0; i < 16; ++i) a.in[i] = (const float*)d_in[i];
    a.out = (float*)d_out; a.ws = (unsigned char*)d_ws;
    if (hipMemsetAsync((char*)d_ws + WS_CTL, 0, CTL_ZERO_BYTES, stream) != hipSuccess) { fprintf(stderr, "kernel_launch: memset failed\n"); return; }
    a.ph_lo = 0; a.ph_hi = N_PHASES;
    hipLaunchKernelGGL(fwd_kernel, dim3(grid), dim3(NTHREADS), LDS_BYTES, stream, a);
}
```

```cpp
#include <hip/hip_runtime.h>
#include <cstdio>
#include <cstdint>

#define GAS __attribute__((address_space(1)))
#define LAS __attribute__((address_space(3)))
typedef unsigned short bf16;
typedef short bf16x8 __attribute__((ext_vector_type(8)));
typedef short s16x4 __attribute__((ext_vector_type(4)));
typedef float f32x4 __attribute__((ext_vector_type(4)));
typedef float f32x16 __attribute__((ext_vector_type(16)));
typedef unsigned u32x4 __attribute__((ext_vector_type(4)));
typedef unsigned u32x2 __attribute__((ext_vector_type(2)));

constexpr int S = 8192, D = 4096, NH = 16, HD = 128, FW = 2048, PW = 2048, FFN = 11008, INC = 16400, D6 = 6 * D;
constexpr int NZ = 16384;
constexpr int NGU = 2 * FFN;
constexpr float LN_EPS = 1e-5f;
constexpr float ALPHA = 1.189207115002721f;
constexpr float ATT_SCALE = 0.08838834764831845f;
constexpr float INV_ATT_SCALE = 11.313708498984761f;
constexpr int NWAVES = 8, NTHREADS = 512;

constexpr size_t MiB = 1u << 20;
constexpr size_t WS_CTL = 0;
constexpr size_t WS_MODP = 1 * MiB;
constexpr size_t WS_MOD = 2 * MiB;
constexpr size_t WS_FL = 3 * MiB;
constexpr size_t WS_BK = 4 * MiB;
constexpr size_t WS_WF = 5 * MiB;
constexpr size_t WS_WZ = 8 * MiB;
constexpr size_t WS_WA = WS_WZ + 128 * MiB;
constexpr size_t WS_WP = WS_WA + 16 * MiB;
constexpr size_t WS_WO = WS_WP + 4 * MiB;
constexpr size_t WS_WGU = WS_WO + 32 * MiB;
constexpr size_t WS_WD = WS_WGU + 172 * MiB;
constexpr size_t WS_U = WS_WD + 86 * MiB;
constexpr size_t WS_QH = WS_U + 64 * MiB;
constexpr size_t WS_KH = WS_QH + 32 * MiB;
constexpr size_t WS_VH = WS_KH + 32 * MiB;
constexpr size_t WS_VT = WS_VH + 32 * MiB;
constexpr size_t WS_PP = WS_VT + 32 * MiB;
constexpr size_t WS_GA = WS_PP + 32 * MiB;
constexpr size_t WS_GP = WS_GA + 64 * MiB;
constexpr size_t WS_ACT = WS_QH;
constexpr size_t WS_PL = WS_GP + 64 * MiB;
constexpr size_t WS_AO = WS_PL + 32 * MiB;
constexpr size_t WS_T = WS_AO + 32 * MiB;
constexpr size_t WS_MX = WS_T + 128 * MiB;
constexpr size_t WS_Y = WS_MX + 64 * MiB;
constexpr size_t WS_X1 = WS_Y + 128 * MiB;
constexpr size_t WS_END = WS_X1 + 128 * MiB;
static_assert(WS_QH + 172 * MiB <= WS_GP && WS_KH == WS_QH + 32 * MiB && WS_VH == WS_KH + 32 * MiB, "ACT overlay / QKV contiguity");

constexpr int LDS_BYTES = 147456;
constexpr int MISC_OFF = 131072 + 320;
constexpr int CW_BAR = 4096;
constexpr size_t CTL_ZERO_BYTES = 1u << 20;

__device__ __forceinline__ unsigned cvt_pk_bf16(float lo, float hi) { unsigned r; asm volatile("v_cvt_pk_bf16_f32 %0, %1, %2" : "=v"(r) : "v"(lo), "v"(hi)); return r; }
__device__ __forceinline__ bf16 f2bf(float f) { return (bf16)(cvt_pk_bf16(f, 0.f) & 0xffffu); }
__device__ __forceinline__ float bf2f(bf16 b) { return __uint_as_float(((unsigned)b) << 16); }
__device__ __forceinline__ float wave_sum(float v) {
#pragma unroll
    for (int o = 1; o < 64; o <<= 1) v += __shfl_xor(v, o);
    return v;
}
__device__ __forceinline__ float sigmoidf_(float x) { return 1.0f / (1.0f + __expf(-x)); }
#define LDS_WAIT() asm volatile("s_waitcnt lgkmcnt(0)" ::: "memory")
#define VM_WAIT() asm volatile("s_waitcnt vmcnt(0)" ::: "memory")

struct Ctx {
    LAS unsigned char* lds;
    int tid, lane, wave, G;
    const float *x, *c, *w_ada, *b_ada, *w_in, *b_forget, *w_attn_out, *w_pool, *pool_scale, *w_out, *ln1_g, *ln1_b, *w_gate_up, *w_down, *ln2_g, *ln2_b;
    float* out;
    unsigned char* ws;
};
#define WSP(T, off) ((T*)(C.ws + (off)))

__device__ __forceinline__ void conv_item(const float* W, int ldw, int k0, int srcn0, bf16* dst, int ldd, int dstr0, const float* rscale, LAS float* scr, int lane) {
#pragma unroll 8
    for (int i = 0; i < 32; ++i) { const int kk = 2 * i + (lane >> 5); scr[kk * 33 + (lane & 31)] = W[(size_t)(k0 + kk) * ldw + srcn0 + (lane & 31)]; }
    LDS_WAIT(); asm volatile("" ::: "memory");
    const int c = lane & 7;
#pragma unroll
    for (int j = 0; j < 4; ++j) { const int n = (lane >> 3) + 8 * j; const LAS float* s = scr + (8 * c) * 33 + n;
        const float sc = rscale ? rscale[dstr0 + n] : 1.0f;
        u32x4 o; o.x = cvt_pk_bf16(s[0 * 33] * sc, s[1 * 33] * sc); o.y = cvt_pk_bf16(s[2 * 33] * sc, s[3 * 33] * sc); o.z = cvt_pk_bf16(s[4 * 33] * sc, s[5 * 33] * sc); o.w = cvt_pk_bf16(s[6 * 33] * sc, s[7 * 33] * sc);
        *(u32x4*)(dst + (size_t)(dstr0 + n) * ldd + k0 + 8 * c) = o; }
    LDS_WAIT(); asm volatile("" ::: "memory");
}

__device__ __forceinline__ void ph_prologue(Ctx& C) {
    {
        LAS float* sl = (LAS float*)C.lds;
        LAS float* red = sl + 512;
        float* modp = WSP(float, WS_MODP);
        for (int task = blockIdx.x; task < 256; task += C.G) {
            const int kg = task >> 5, cs = task & 31;
            { const float cv = C.c[512 * kg + C.tid]; sl[C.tid] = cv / (1.0f + __expf(-cv)); }
            __syncthreads();
            f32x4 acc[3] = {};
            const f32x4* wrow = (const f32x4*)(C.w_ada + (size_t)(512 * kg + 64 * C.wave) * D6) + cs * 192 + C.lane;
#pragma unroll 4
            for (int r = 0; r < 64; ++r) { const float s = sl[64 * C.wave + r];
#pragma unroll
                for (int q = 0; q < 3; ++q) { const f32x4 v = wrow[(size_t)r * (D6 / 4) + 64 * q]; acc[q] += v * s; } }
#pragma unroll
            for (int q = 0; q < 3; ++q) *(LAS f32x4*)(red + C.wave * 768 + (C.lane + 64 * q) * 4) = acc[q];
            __syncthreads();
            if (C.tid < 192) { f32x4 s = {0.f, 0.f, 0.f, 0.f};
#pragma unroll
                for (int w = 0; w < 8; ++w) s += *(LAS f32x4*)(red + w * 768 + C.tid * 4);
                *(f32x4*)(modp + (size_t)kg * D6 + cs * 768 + C.tid * 4) = s; }
            __syncthreads();
        }
    }
    {
        LAS float* scr = (LAS float*)(C.lds + C.wave * 16384);
        const int gw = blockIdx.x * NWAVES + C.wave, NGW = C.G * NWAVES;
        constexpr int I_ZA = 64 * 192, I_ZB = 64 * 320, I_A = 32 * 128, I_P = 4 * 8 * 32, I_O = 64 * 128, I_GU = 64 * 688, I_D = 172 * 128;
        constexpr int NITEMS = I_ZA + I_ZB + I_A + I_P + I_O + I_GU + I_D;
        for (int it = gw; it < NITEMS; it += NGW) {
            int r = it;
            if (r < I_GU) { const int kb = r / 688, nb = r % 688, r0 = 32 * nb, tile = r0 >> 8, within = r0 & 255, half = within >> 7, j0 = tile * 128 + (within & 127);
                conv_item(C.w_gate_up, NGU, 64 * kb, half * FFN + j0, WSP(bf16, WS_WGU), D, r0, nullptr, scr, C.lane); continue; } r -= I_GU;
            if (r < I_D) { const int kb = r / 128, nb = r % 128; conv_item(C.w_down, D, 64 * kb, 32 * nb, WSP(bf16, WS_WD), FFN, 32 * nb, nullptr, scr, C.lane); continue; } r -= I_D;
            if (r < I_O) { const int kb = r / 128, nb = r % 128; conv_item(C.w_out, D, 64 * kb, 32 * nb, WSP(bf16, WS_WO), D, 32 * nb, nullptr, scr, C.lane); continue; } r -= I_O;
            if (r < I_A) { const int kb = r / 128, nb = r % 128; conv_item(C.w_attn_out, D, 64 * kb, 32 * nb, WSP(bf16, WS_WA), FW, 32 * nb, nullptr, scr, C.lane); continue; } r -= I_A;
            if (r < I_P) { const int g = r / 256, rr = r % 256, kb = rr / 32, nb = rr % 32;
                conv_item(C.w_pool + (size_t)g * 512 * 1024, 1024, 64 * kb, 32 * nb, WSP(bf16, WS_WP), 512, 1024 * g + 32 * nb, C.pool_scale, scr, C.lane); continue; } r -= I_P;
            if (r < I_ZA) { const int kb = r / 192, nb = r % 192; conv_item(C.w_in, INC, 64 * kb, 32 * nb, WSP(bf16, WS_WZ), D, 32 * nb, nullptr, scr, C.lane); continue; } r -= I_ZA;
            { const int kb = r / 320, nb = r % 320; conv_item(C.w_in, INC, 64 * kb, 6160 + 32 * nb, WSP(bf16, WS_WZ), D, 6144 + 32 * nb, nullptr, scr, C.lane); }
        }
        bf16* wf = WSP(bf16, WS_WF);
        for (int g = blockIdx.x * NTHREADS + C.tid; g < 16 * D; g += C.G * NTHREADS) { const int h = g & 15, k = g >> 4; wf[h * D + k] = f2bf(C.w_in[(size_t)k * INC + 6144 + h]); }
    }
}

__device__ __forceinline__ void row_load(const float* rowp, int lane, f32x4 (&v)[16]) {
    const f32x4* p = (const f32x4*)rowp + lane;
#pragma unroll
    for (int j = 0; j < 16; ++j) v[j] = p[64 * j];
}
__device__ __forceinline__ void row_normalize(f32x4 (&v)[16]) {
    float s = 0.f;
#pragma unroll
    for (int j = 0; j < 16; ++j) s += (v[j].x + v[j].y) + (v[j].z + v[j].w);
    const float mean = wave_sum(s) * (1.0f / D); float s2 = 0.f;
#pragma unroll
    for (int j = 0; j < 16; ++j) { v[j] = v[j] - mean; s2 += (v[j].x * v[j].x + v[j].y * v[j].y) + (v[j].z * v[j].z + v[j].w * v[j].w); }
    const float rstd = 1.0f / sqrtf(wave_sum(s2) * (1.0f / D) + LN_EPS);
#pragma unroll
    for (int j = 0; j < 16; ++j) v[j] = v[j] * rstd;
}
__device__ __forceinline__ void mod_to_lds(Ctx& C, LAS float* dst, int chunk, float add) {
    const float* modp = WSP(float, WS_MODP);
    for (int c = C.tid; c < D; c += NTHREADS) { float s = C.b_ada[chunk * D + c];
#pragma unroll
        for (int kg = 0; kg < 8; ++kg) s += modp[(size_t)kg * D6 + chunk * D + c];
        dst[c] = s + add; }
}

__device__ __forceinline__ void ph_ln1(Ctx& C) {
    LAS float* sc = (LAS float*)C.lds; LAS float* sh = sc + D;
    mod_to_lds(C, sh, 0, 0.f); mod_to_lds(C, sc, 1, 1.f);
    { const float* modp = WSP(float, WS_MODP); float* mod = WSP(float, WS_MOD);
      for (int j = blockIdx.x * NTHREADS + C.tid; j < D6; j += C.G * NTHREADS) { float s = C.b_ada[j];
#pragma unroll
          for (int kg = 0; kg < 8; ++kg) s += modp[(size_t)kg * D6 + j];
          mod[j] = s; } }
    __syncthreads();
    bf16* U = WSP(bf16, WS_U);
    for (int row = blockIdx.x * NWAVES + C.wave; row < S; row += C.G * NWAVES) {
        f32x4 v[16]; row_load(C.x + (size_t)row * D, C.lane, v); row_normalize(v);
        u32x2* o = (u32x2*)(U + (size_t)row * D) + C.lane;
#pragma unroll
        for (int j = 0; j < 16; ++j) { const f32x4 a = *(LAS f32x4*)(sc + 4 * (C.lane + 64 * j)), b = *(LAS f32x4*)(sh + 4 * (C.lane + 64 * j)); const f32x4 r = v[j] * a + b;
            u32x2 w; w.x = cvt_pk_bf16(r.x, r.y); w.y = cvt_pk_bf16(r.z, r.w); o[64 * j] = w; }
    }
}
__device__ __forceinline__ void ph_ln_mid(Ctx& C) {
    LAS float* g = (LAS float*)C.lds; LAS float* b = g + D; LAS float* sc = b + D; LAS float* sh = sc + D;
    const float* mod = WSP(float, WS_MOD);
    for (int c = C.tid; c < D; c += NTHREADS) { g[c] = C.ln1_g[c]; b[c] = C.ln1_b[c]; sh[c] = mod[3 * D + c]; sc[c] = 1.0f + mod[4 * D + c]; }
    __syncthreads();
    bf16* U = WSP(bf16, WS_U); const float* Y = WSP(float, WS_Y); float* X1 = WSP(float, WS_X1);
    for (int row = blockIdx.x * NWAVES + C.wave; row < S; row += C.G * NWAVES) {
        f32x4 v[16]; row_load(Y + (size_t)row * D, C.lane, v); row_normalize(v);
        f32x4* xo = (f32x4*)(X1 + (size_t)row * D) + C.lane;
#pragma unroll
        for (int j = 0; j < 16; ++j) { const f32x4 a = *(LAS f32x4*)(g + 4 * (C.lane + 64 * j)), bb = *(LAS f32x4*)(b + 4 * (C.lane + 64 * j)); v[j] = v[j] * a + bb; xo[64 * j] = v[j]; }
        row_normalize(v);
        u32x2* o = (u32x2*)(U + (size_t)row * D) + C.lane;
#pragma unroll
        for (int j = 0; j < 16; ++j) { const f32x4 a = *(LAS f32x4*)(sc + 4 * (C.lane + 64 * j)), bb = *(LAS f32x4*)(sh + 4 * (C.lane + 64 * j)); const f32x4 r = v[j] * a + bb;
            u32x2 w; w.x = cvt_pk_bf16(r.x, r.y); w.y = cvt_pk_bf16(r.z, r.w); o[64 * j] = w; }
    }
}
__device__ __forceinline__ void ph_ln_final(Ctx& C) {
    LAS float* g = (LAS float*)C.lds; LAS float* b = g + D;
    for (int c = C.tid; c < D; c += NTHREADS) { g[c] = C.ln2_g[c]; b[c] = C.ln2_b[c]; }
    __syncthreads();
    const float* Y = WSP(float, WS_Y);
    for (int row = blockIdx.x * NWAVES + C.wave; row < S; row += C.G * NWAVES) {
        f32x4 v[16]; row_load(Y + (size_t)row * D, C.lane, v); row_normalize(v);
        f32x4* xo = (f32x4*)(C.out + (size_t)row * D) + C.lane;
#pragma unroll
        for (int j = 0; j < 16; ++j) { const f32x4 a = *(LAS f32x4*)(g + 4 * (C.lane + 64 * j)), bb = *(LAS f32x4*)(b + 4 * (C.lane + 64 * j)); xo[64 * j] = v[j] * a + bb; }
    }
}

__device__ __forceinline__ void ph_flogit(Ctx& C) {
    const bf16* U = WSP(bf16, WS_U); const bf16* WF = WSP(bf16, WS_WF); float* FL = WSP(float, WS_FL);
    LAS float* red = (LAS float*)C.lds;
    const int fr = C.lane & 15, fq = C.lane >> 4, rg = C.wave >> 2, kq = C.wave & 3;
    for (int blk = blockIdx.x; blk < S / 32; blk += C.G) {
        const int row = 32 * blk + 16 * rg + fr;
        const bf16* ap = U + (size_t)row * D + 1024 * kq + 8 * fq; const bf16* bp = WF + (size_t)fr * D + 1024 * kq + 8 * fq;
        f32x4 acc = {0.f, 0.f, 0.f, 0.f};
#pragma unroll 8
        for (int k = 0; k < 32; ++k) { const bf16x8 a = *(const bf16x8*)(ap + 32 * k), b = *(const bf16x8*)(bp + 32 * k); acc = __builtin_amdgcn_mfma_f32_16x16x32_bf16(a, b, acc, 0, 0, 0); }
        *(LAS f32x4*)(red + C.wave * 256 + C.lane * 4) = acc;
        __syncthreads();
        if (kq == 0) { f32x4 s = acc;
#pragma unroll
            for (int w = 1; w < 4; ++w) s += *(LAS f32x4*)(red + (C.wave + w) * 256 + C.lane * 4);
            s += C.b_forget[fr];
            *(f32x4*)(FL + (size_t)fr * S + 32 * blk + 16 * rg + 4 * fq) = s; }
        __syncthreads();
    }
}

__device__ __forceinline__ void ph_scan_pool(Ctx& C) {
    LAS float* wsum = (LAS float*)C.lds;
    for (int h = blockIdx.x; h < NH; h += C.G) {
        const float* fl = WSP(float, WS_FL) + (size_t)h * S; float* bk = WSP(float, WS_BK) + (size_t)h * S;
        float v[16];
#pragma unroll
        for (int q = 0; q < 4; ++q) { const f32x4 t = *(const f32x4*)(fl + 16 * C.tid + 4 * q); v[4 * q] = t.x; v[4 * q + 1] = t.y; v[4 * q + 2] = t.z; v[4 * q + 3] = t.w; }
        float run = 0.f;
#pragma unroll
        for (int i = 0; i < 16; ++i) { const float xx = v[i]; const float ls = -(fmaxf(-xx, 0.f) + log1pf(__expf(-fabsf(xx)))); run += ls; v[i] = run; }
        float incl = run;
#pragma unroll
        for (int o = 1; o < 64; o <<= 1) { const float t = __shfl_up(incl, o); if (C.lane >= o) incl += t; }
        if (C.lane == 63) wsum[C.wave] = incl;
        __syncthreads();
        float off = incl - run;
        for (int w = 0; w < C.wave; ++w) off += wsum[w];
#pragma unroll
        for (int q = 0; q < 4; ++q) { f32x4 t; t.x = -(v[4 * q] + off) * INV_ATT_SCALE; t.y = -(v[4 * q + 1] + off) * INV_ATT_SCALE; t.z = -(v[4 * q + 2] + off) * INV_ATT_SCALE; t.w = -(v[4 * q + 3] + off) * INV_ATT_SCALE;
            *(f32x4*)(bk + 16 * C.tid + 4 * q) = t; }
        __syncthreads();
    }
    const bf16* PP = WSP(bf16, WS_PP); bf16* PL = WSP(bf16, WS_PL);
    for (int gt = blockIdx.x * NTHREADS + C.tid; gt < (S / 16) * (PW / 8); gt += C.G * NTHREADS) {
        const int cc = gt & 255, rc = gt >> 8, g = cc >> 6, w = 2 << g, r0 = 16 * rc;
        const bf16* base = PP + 8 * cc; float sum[8] = {0.f, 0.f, 0.f, 0.f, 0.f, 0.f, 0.f, 0.f};
        for (int j = 1; j < w; ++j) { const int r = r0 - j; if (r >= 0) { const bf16x8 t = *(const bf16x8*)(base + (size_t)r * PW);
#pragma unroll
                for (int e = 0; e < 8; ++e) sum[e] += bf2f((bf16)t[e]); } }
        for (int i = 0; i < 16; ++i) { const int r = r0 + i; const bf16x8 t = *(const bf16x8*)(base + (size_t)r * PW);
            const float inv = 1.0f / (float)((r + 1) < w ? (r + 1) : w); float o[8];
#pragma unroll
            for (int e = 0; e < 8; ++e) { const float pv = bf2f((bf16)t[e]); sum[e] += pv; o[e] = sum[e] * inv - pv; }
            u32x4 ow; ow.x = cvt_pk_bf16(o[0], o[1]); ow.y = cvt_pk_bf16(o[2], o[3]); ow.z = cvt_pk_bf16(o[4], o[5]); ow.w = cvt_pk_bf16(o[6], o[7]);
            *(u32x4*)(PL + (size_t)r * PW + 8 * cc) = ow;
            const int ro = r - w + 1; if (ro >= 0) { const bf16x8 t2 = *(const bf16x8*)(base + (size_t)ro * PW);
#pragma unroll
                for (int e = 0; e < 8; ++e) sum[e] -= bf2f((bf16)t2[e]); } }
    }
}

template <bool PAIR, class Epi>
__device__ __forceinline__ void sgemm_phase(Ctx& C, const bf16* A, int lda, const bf16* Bt, int ldb, int M, int N, int K, int grp_cols, int grp_off, const Epi& E) {
    const int fr = C.lane & 15, fq = C.lane >> 4, wm = C.wave >> 2, wn = C.wave & 3;
    const int nTn = N / 256, nT = (M / 128) * nTn;
    for (int t = blockIdx.x; t < nT; t += C.G) {
        const int tm = t / nTn, tn = t % nTn, row0 = tm * 128 + wm * 64;
        const bf16* Ab = A + (size_t)((tn * 256) / grp_cols) * grp_off;
        int brow[4];
#pragma unroll
        for (int j = 0; j < 4; ++j) brow[j] = PAIR ? (tn * 256 + (j >> 1) * 128 + wn * 32 + (j & 1) * 16 + fr) : (tn * 256 + wn * 64 + 16 * j + fr);
        f32x4 acc[4][4];
#pragma unroll
        for (int i = 0; i < 4; ++i)
#pragma unroll
            for (int j = 0; j < 4; ++j) acc[i][j] = (f32x4){0.f, 0.f, 0.f, 0.f};
        for (int k0 = 0; k0 < K; k0 += 32) {
            bf16x8 a[4], b[4];
#pragma unroll
            for (int i = 0; i < 4; ++i) a[i] = *(const bf16x8*)(Ab + (size_t)(row0 + 16 * i + fr) * lda + k0 + 8 * fq);
#pragma unroll
            for (int j = 0; j < 4; ++j) b[j] = *(const bf16x8*)(Bt + (size_t)brow[j] * ldb + k0 + 8 * fq);
#pragma unroll
            for (int i = 0; i < 4; ++i)
#pragma unroll
                for (int j = 0; j < 4; ++j) acc[i][j] = __builtin_amdgcn_mfma_f32_16x16x32_bf16(a[i], b[j], acc[i][j], 0, 0, 0);
        }
        if constexpr (PAIR) {
#pragma unroll
            for (int i = 0; i < 4; ++i)
#pragma unroll
                for (int j = 0; j < 2; ++j)
#pragma unroll
                    for (int e = 0; e < 4; ++e) E(row0 + 16 * i + 4 * fq + e, tn * 128 + wn * 32 + j * 16 + fr, acc[i][j][e], acc[i][j + 2][e]);
        } else {
#pragma unroll
            for (int i = 0; i < 4; ++i)
#pragma unroll
                for (int j = 0; j < 4; ++j)
#pragma unroll
                    for (int e = 0; e < 4; ++e) E(row0 + 16 * i + 4 * fq + e, tn * 256 + wn * 64 + 16 * j + fr, acc[i][j][e]);
        }
    }
}

__device__ __forceinline__ int crow(int r, int hi) { return (r & 3) + 8 * (r >> 2) + 4 * hi; }
__device__ __forceinline__ void ph_attn_simple(Ctx& C) {
    const bf16* QH = WSP(bf16, WS_QH); const bf16* KH = WSP(bf16, WS_KH); const bf16* VT = WSP(bf16, WS_VT); const float* BK = WSP(float, WS_BK); bf16* AO = WSP(bf16, WS_AO);
    LAS float* wl = (LAS float*)C.lds + C.wave * 64;
    const int c32 = C.lane & 31, hi = C.lane >> 5;
    constexpr float C2 = 1.4426950408889634f * ATT_SCALE;
    const int gw = blockIdx.x * NWAVES + C.wave, NGW = C.G * NWAVES;
    for (int u = gw; u < NH * 256; u += NGW) {
        const int h = u & 15, idx = u >> 4, half = idx >> 7, qb = half ? (idx & 127) : 255 - (idx & 127);
        const int q0 = 32 * qb;
        const bf16* Qp = QH + ((size_t)h * S + q0 + c32) * HD + 8 * hi;
        bf16x8 qf[8];
#pragma unroll
        for (int d0 = 0; d0 < 8; ++d0) qf[d0] = *(const bf16x8*)(Qp + 16 * d0);
        f32x16 o[4];
#pragma unroll
        for (int d = 0; d < 4; ++d)
#pragma unroll
            for (int r = 0; r < 16; ++r) o[d][r] = 0.f;
        float m_run = -1e30f, l_run = 0.f;
        for (int jt = 0; jt <= qb; ++jt) {
            const int k0 = 32 * jt;
            f32x16 p;
#pragma unroll
            for (int r = 0; r < 16; ++r) p[r] = 0.f;
            const bf16* Kp = KH + ((size_t)h * S + k0 + c32) * HD + 8 * hi;
#pragma unroll
            for (int d0 = 0; d0 < 8; ++d0) { const bf16x8 kf = *(const bf16x8*)(Kp + 16 * d0); p = __builtin_amdgcn_mfma_f32_32x32x16_bf16(kf, qf[d0], p, 0, 0, 0); }
            float mx = -__builtin_inff();
#pragma unroll
            for (int r = 0; r < 16; ++r) { const int key = k0 + crow(r, hi); float sv = (p[r] + BK[(size_t)h * S + key]) * C2; if (key > q0 + c32) sv = -__builtin_inff(); p[r] = sv; mx = fmaxf(mx, sv); }
            mx = fmaxf(mx, __shfl_xor(mx, 32));
            const float m_new = fmaxf(m_run, mx), alpha = exp2f(m_run - m_new); m_run = m_new;
            float ps = 0.f;
#pragma unroll
            for (int r = 0; r < 16; ++r) { p[r] = exp2f(p[r] - m_new); ps += p[r]; }
            ps += __shfl_xor(ps, 32);
            l_run = l_run * alpha + ps;
            if (hi == 0) wl[c32] = alpha;
            LDS_WAIT(); asm volatile("" ::: "memory");
#pragma unroll
            for (int r = 0; r < 16; ++r) { const float a = wl[crow(r, hi)];
#pragma unroll
                for (int d = 0; d < 4; ++d) o[d][r] *= a; }
            LDS_WAIT(); asm volatile("" ::: "memory");
            bf16x8 pa[2];
#pragma unroll
            for (int ks = 0; ks < 2; ++ks) { u32x4 w; w.x = cvt_pk_bf16(p[8 * ks + 0], p[8 * ks + 1]); w.y = cvt_pk_bf16(p[8 * ks + 2], p[8 * ks + 3]); w.z = cvt_pk_bf16(p[8 * ks + 4], p[8 * ks + 5]); w.w = cvt_pk_bf16(p[8 * ks + 6], p[8 * ks + 7]); pa[ks] = *reinterpret_cast<bf16x8*>(&w); }
#pragma unroll
            for (int d = 0; d < 4; ++d) { const bf16* vp = VT + ((size_t)h * HD + 32 * d + c32) * S + k0 + 4 * hi;
#pragma unroll
                for (int ks = 0; ks < 2; ++ks) { const s16x4 v0 = *(const s16x4*)(vp + 16 * ks), v1 = *(const s16x4*)(vp + 16 * ks + 8);
                    const bf16x8 vb = {v0[0], v0[1], v0[2], v0[3], v1[0], v1[1], v1[2], v1[3]};
                    o[d] = __builtin_amdgcn_mfma_f32_32x32x16_bf16(pa[ks], vb, o[d], 0, 0, 0); } }
        }
        if (hi == 0) wl[c32] = 1.0f / l_run;
        LDS_WAIT(); asm volatile("" ::: "memory");
#pragma unroll
        for (int r = 0; r < 16; ++r) { const int qr = crow(r, hi); const float il = wl[qr];
#pragma unroll
            for (int d = 0; d < 4; ++d) AO[(size_t)(q0 + qr) * FW + h * HD + 32 * d + c32] = f2bf(o[d][r] * il); }
        LDS_WAIT(); asm volatile("" ::: "memory");
    }
}

struct EZs { bf16 *QH, *VT, *PP, *GA, *GP;
    __device__ __forceinline__ void operator()(int row, int col, float v) const {
        if (col < 6144) { const int part = col >> 11, h = (col & 2047) >> 7, d = col & 127; bf16* dst = QH + (size_t)part * (16u << 20); const bf16 b = f2bf(v);
            dst[((size_t)h * S + row) * HD + d] = b; if (part == 2) VT[((size_t)h * HD + d) * S + row] = b; }
        else if (col < 8192) PP[(size_t)row * PW + (col - 6144)] = f2bf(v);
        else if (col < 12288) GA[(size_t)row * D + (col - 8192)] = f2bf(sigmoidf_(v));
        else GP[(size_t)row * D + (col - 12288)] = f2bf(sigmoidf_(v)); } };
struct ETs { const bf16* GP; float* T;
    __device__ __forceinline__ void operator()(int row, int col, float v) const { T[(size_t)row * D + col] = bf2f(GP[(size_t)row * D + col]) * v; } };
struct EMs { const bf16* GA; const float* T; bf16* MX;
    __device__ __forceinline__ void operator()(int row, int col, float v) const { MX[(size_t)row * D + col] = f2bf(bf2f(GA[(size_t)row * D + col]) * v + T[(size_t)row * D + col]); } };
struct EYs { const float* base; const float* gate; float* Y;
    __device__ __forceinline__ void operator()(int row, int col, float v) const { Y[(size_t)row * D + col] = ALPHA * base[(size_t)row * D + col] + gate[col] * v; } };
struct EGUs { bf16* ACT;
    __device__ __forceinline__ void operator()(int row, int j, float g, float up) const { ACT[(size_t)row * FFN + j] = f2bf(g / (1.0f + __expf(-g)) * up); } };

namespace pg8 {
constexpr int BM = 256, BK = 64, HALF = 128, HTB = HALF * BK * 2, STAGE_BYTES = 8 * HTB, NXCD = 8, WGM = 8;
__host__ __device__ __forceinline__ int lds_byte(int r, int c) { const int st = (r >> 4) * 2 + (c >> 5), rr = r & 15, cc = c & 31, ob = rr * 64 + cc * 2; return st * 1024 + (ob ^ (((ob >> 9) & 1) << 5)); }
__host__ __device__ __forceinline__ void stage_rc(int b, int& R, int& C) { const int st = b / 1024, sb = b % 1024, swz = sb ^ (((sb >> 9) & 1) << 5); R = (st >> 1) * 16 + swz / 64; C = (st & 1) * 32 + (swz % 64) / 2; }
__host__ __device__ __forceinline__ int perm32(int rho) { const int n = rho >> 4, i = rho & 15; return 8 * (i >> 2) + 4 * n + (i & 3); }
struct Unit { int pm, pn; };
struct Gemm { const bf16* A; const bf16* Bt; int M, N, K, lda, grp_tiles, grp_off; };
struct StaticOrder {
    int nM, nN, nwg, G, c;
    __host__ __device__ void init(int M, int N, int G_, int c_) { nM = M / BM; nN = N / BM; nwg = nM * nN; G = G_; c = c_; }
    __host__ __device__ bool next(int i, Unit& u) const {
        const long L = (long)i * G + c; if (L >= nwg) return false;
        int wgid = (int)L; { const int q = nwg / NXCD, r = nwg % NXCD, xcd = wgid % NXCD, off = wgid / NXCD; wgid = (xcd < r ? xcd * (q + 1) : r * (q + 1) + (xcd - r) * q) + off; }
        const int nig = WGM * nN, gid = wgid / nig, fm = gid * WGM, gsz = (nM - fm) < WGM ? (nM - fm) : WGM;
        u.pm = fm + ((wgid % nig) % gsz); u.pn = (wgid % nig) / gsz; return true;
    }
    __device__ __forceinline__ void a_ready(const Unit&) const {}
    __device__ __forceinline__ void done(const Unit&) const {}
};
template <class Epi, class Sched, bool ALIGN_EPI = false, bool SP2 = false>
__device__ __forceinline__ void gemm_phase(LAS unsigned char* lds, const Gemm g, const Sched& S, const Epi& E) {
    const int tid = threadIdx.x, wid = __builtin_amdgcn_readfirstlane(tid >> 6), lane = tid & 63, wr = wid >> 2, wc = wid & 3, fr = lane & 15, fq = lane >> 4;
    const int K = g.K, nt = K / BK, lda = g.lda;
    unsigned voffA[2], voffB[2];
#pragma unroll
    for (int i = 0; i < 2; ++i) { int R, Cc; stage_rc(tid * 16 + i * 8192, R, Cc); const int Rb = Epi::PERM ? ((R & ~31) + perm32(R & 31)) : R;
        voffA[i] = (unsigned)(R * lda + Cc) * 2u; voffB[i] = (unsigned)(Rb * K + Cc) * 2u; }
    const size_t kstep = (size_t)(BK * 2);
    const size_t hstepA = (size_t)HALF * lda * 2, hstepB = (size_t)HALF * K * 2;
    const size_t tstepA = 2 * hstepA, tstepB = 2 * hstepB;
    const unsigned ldsw = (unsigned)wid * 1024u;
    const int aoff = lds_byte(wr * 64 + fr, fq * 8), boff = lds_byte(wc * 32 + fr, fq * 8);
#define PG8_SA(b, h) (((b) * 2 + (h)) * HTB)
#define PG8_SB(b, h) ((4 + (b) * 2 + (h)) * HTB)
#define PG8_STAGE(bufoff, gbase, voff) do { _Pragma("unroll") for (int _i = 0; _i < 2; ++_i) \
        __builtin_amdgcn_global_load_lds((const unsigned*)((const char*)(gbase) + (voff)[_i]), (LAS unsigned*)(lds + (bufoff) + ldsw + _i * 8192), 16, 0, 0); } while (0)
#define PG8_LDA(dst, b, h) do { _Pragma("unroll") for (int m = 0; m < 4; ++m) _Pragma("unroll") for (int k = 0; k < 2; ++k) dst[m][k] = *(const LAS bf16x8*)(lds + PG8_SA(b, h) + aoff + m * 2048 + k * 1024); } while (0)
#define PG8_LDB(dst, b, h) do { _Pragma("unroll") for (int n = 0; n < 2; ++n) _Pragma("unroll") for (int k = 0; k < 2; ++k) dst[n][k] = *(const LAS bf16x8*)(lds + PG8_SB(b, h) + boff + n * 2048 + k * 1024); } while (0)
#define PG8_MMA(ai, bj, At, Bt) do { __builtin_amdgcn_s_setprio(1); _Pragma("unroll") for (int m = 0; m < 4; ++m) _Pragma("unroll") for (int n = 0; n < 2; ++n) _Pragma("unroll") for (int k = 0; k < 2; ++k) \
        acc[ai][bj][m][n] = __builtin_amdgcn_mfma_f32_16x16x32_bf16(Bt[n][k], At[m][k], acc[ai][bj][m][n], 0, 0, 0); __builtin_amdgcn_s_setprio(0); } while (0)
#define PG8_WAIT_V(n) asm volatile("s_waitcnt vmcnt(" #n ")" ::: "memory")
#define PG8_WAIT_L(n) asm volatile("s_waitcnt lgkmcnt(" #n ")" ::: "memory")
#define PG8_BAR __builtin_amdgcn_s_barrier()
#define PG8_SCHED __builtin_amdgcn_sched_barrier(0)
#define PG8_ABASE(u) ((const char*)g.A + (size_t)(u).pm * tstepA + (size_t)((u).pn / g.grp_tiles) * g.grp_off * 2)
    Unit cur, nxt; int ui = 0;
    if (!S.next(0, cur)) return;
    f32x4 acc[2][2][4][2];
#pragma unroll
    for (int a = 0; a < 2; ++a)
#pragma unroll
        for (int b = 0; b < 2; ++b)
#pragma unroll
            for (int m = 0; m < 4; ++m)
#pragma unroll
                for (int n = 0; n < 2; ++n) acc[a][b][m][n] = (f32x4){0.f, 0.f, 0.f, 0.f};
    bf16x8 At[4][2], B0[2][2], B1[2][2];
    const char* cA = PG8_ABASE(cur); const char* cB = (const char*)g.Bt + (size_t)cur.pn * tstepB;
    S.a_ready(cur);
    if constexpr (SP2) {
        PG8_STAGE(PG8_SB(0, 0), cB, voffB); PG8_STAGE(PG8_SB(0, 1), cB + hstepB, voffB); PG8_STAGE(PG8_SA(0, 0), cA, voffA); PG8_STAGE(PG8_SA(0, 1), cA + hstepA, voffA);
        if (wr == 1) PG8_BAR;
        PG8_WAIT_V(2); PG8_BAR;
        PG8_STAGE(PG8_SB(1, 0), cB + kstep, voffB); PG8_STAGE(PG8_SA(1, 0), cA + kstep, voffA); PG8_STAGE(PG8_SB(1, 1), cB + hstepB + kstep, voffB);
        PG8_WAIT_V(6); PG8_BAR;
    } else {
        PG8_STAGE(PG8_SB(0, 0), cB, voffB); PG8_STAGE(PG8_SA(0, 0), cA, voffA); PG8_STAGE(PG8_SB(0, 1), cB + hstepB, voffB); PG8_STAGE(PG8_SA(0, 1), cA + hstepA, voffA);
        if (wr == 1) PG8_BAR;
        PG8_WAIT_V(4); PG8_BAR;
        PG8_STAGE(PG8_SB(1, 0), cB + kstep, voffB); PG8_STAGE(PG8_SA(1, 0), cA + kstep, voffA); PG8_STAGE(PG8_SB(1, 1), cB + hstepB + kstep, voffB);
        PG8_WAIT_V(6); PG8_BAR;
    }
    for (;;) {
        const bool has_next = S.next(ui + 1, nxt);
        const char* nA = has_next ? PG8_ABASE(nxt) : cA; const char* nB = has_next ? (const char*)g.Bt + (size_t)nxt.pn * tstepB : cB;
        for (int t = 0; t < nt; t += 2) {
            const bool last = (t == nt - 2);
            const char* a1 = cA + (size_t)(t + 1) * kstep;
            const char* a2 = last ? nA : cA + (size_t)(t + 2) * kstep; const char* b2 = last ? nB : cB + (size_t)(t + 2) * kstep;
            const char* a3 = a2 + kstep; const char* b3 = b2 + kstep;
            if (last && has_next) S.a_ready(nxt);
            if constexpr (SP2) {
            PG8_LDB(B0, 0, 0); PG8_LDB(B1, 0, 1); PG8_SCHED; PG8_LDA(At, 0, 0); PG8_STAGE(PG8_SA(1, 1), a1 + hstepA, voffA);
            PG8_WAIT_V(8); PG8_WAIT_L(0); PG8_BAR; PG8_MMA(0, 0, At, B0); PG8_MMA(0, 1, At, B1); PG8_BAR; PG8_SCHED;
            PG8_LDA(At, 0, 1); PG8_STAGE(PG8_SB(0, 0), b2, voffB); PG8_STAGE(PG8_SB(0, 1), b2 + hstepB, voffB); PG8_STAGE(PG8_SA(0, 0), a2, voffA);
            PG8_WAIT_V(8); PG8_WAIT_L(0); PG8_BAR; PG8_MMA(1, 0, At, B0); PG8_MMA(1, 1, At, B1); PG8_BAR; PG8_SCHED;
            PG8_LDB(B0, 1, 0); PG8_LDB(B1, 1, 1); PG8_SCHED; PG8_LDA(At, 1, 0); PG8_STAGE(PG8_SA(0, 1), a2 + hstepA, voffA);
            PG8_WAIT_V(8); PG8_WAIT_L(0); PG8_BAR; PG8_MMA(0, 0, At, B0); PG8_MMA(0, 1, At, B1); PG8_BAR; PG8_SCHED;
            PG8_LDA(At, 1, 1); PG8_STAGE(PG8_SB(1, 0), b3, voffB); PG8_STAGE(PG8_SB(1, 1), b3 + hstepB, voffB); PG8_STAGE(PG8_SA(1, 0), a3, voffA);
            PG8_WAIT_V(8); PG8_WAIT_L(0); PG8_BAR; PG8_MMA(1, 0, At, B0); PG8_MMA(1, 1, At, B1); PG8_BAR; PG8_SCHED;
            } else {
            PG8_LDB(B0, 0, 0); PG8_SCHED; PG8_LDA(At, 0, 0); PG8_STAGE(PG8_SA(1, 1), a1 + hstepA, voffA);
            PG8_WAIT_L(8); PG8_BAR; PG8_WAIT_L(0); PG8_MMA(0, 0, At, B0); PG8_BAR; PG8_SCHED;
            PG8_LDB(B1, 0, 1); PG8_STAGE(PG8_SB(0, 0), b2, voffB);
            PG8_BAR; PG8_WAIT_L(0); PG8_MMA(0, 1, At, B1); PG8_BAR;
            PG8_LDA(At, 0, 1); PG8_STAGE(PG8_SA(0, 0), a2, voffA);
            PG8_BAR; PG8_WAIT_L(0); PG8_MMA(1, 0, At, B0); PG8_BAR; PG8_SCHED;
            PG8_STAGE(PG8_SB(0, 1), b2 + hstepB, voffB);
            PG8_WAIT_V(6); PG8_BAR; PG8_MMA(1, 1, At, B1); PG8_BAR;
            PG8_LDB(B0, 1, 0); PG8_SCHED; PG8_LDA(At, 1, 0); PG8_STAGE(PG8_SA(0, 1), a2 + hstepA, voffA);
            PG8_WAIT_L(8); PG8_BAR; PG8_WAIT_L(0); PG8_MMA(0, 0, At, B0); PG8_BAR; PG8_SCHED;
            PG8_LDB(B1, 1, 1); PG8_STAGE(PG8_SB(1, 0), b3, voffB);
            PG8_BAR; PG8_WAIT_L(0); PG8_MMA(0, 1, At, B1); PG8_BAR;
            PG8_LDA(At, 1, 1); PG8_STAGE(PG8_SA(1, 0), a3, voffA);
            PG8_BAR; PG8_WAIT_L(0); PG8_MMA(1, 0, At, B0); PG8_BAR; PG8_SCHED;
            PG8_STAGE(PG8_SB(1, 1), b3 + hstepB, voffB);
            PG8_WAIT_V(6); PG8_BAR; PG8_MMA(1, 1, At, B1); PG8_BAR;
            }
        }
        if constexpr (ALIGN_EPI) { if (wr == 0) PG8_BAR; }
        E(acc, cur, wr, wc, fr, fq); S.done(cur);
        if (!has_next) break;
#pragma unroll
        for (int a = 0; a < 2; ++a)
#pragma unroll
            for (int b = 0; b < 2; ++b)
#pragma unroll
                for (int m = 0; m < 4; ++m)
#pragma unroll
                    for (int n = 0; n < 2; ++n) acc[a][b][m][n] = (f32x4){0.f, 0.f, 0.f, 0.f};
        cur = nxt; cA = nA; cB = nB; ++ui;
        if constexpr (ALIGN_EPI) { if (wr == 1) PG8_BAR; }
    }
    PG8_WAIT_V(0);
    if constexpr (!ALIGN_EPI) { if (wr == 0) PG8_BAR; }
    PG8_BAR;
#undef PG8_SA
#undef PG8_SB
#undef PG8_STAGE
#undef PG8_LDA
#undef PG8_LDB
#undef PG8_MMA
#undef PG8_WAIT_V
#undef PG8_WAIT_L
#undef PG8_BAR
#undef PG8_SCHED
#undef PG8_ABASE
}
__device__ __forceinline__ u32x4 pack8(const f32x4 v0, const f32x4 v1) { u32x4 w; w.x = cvt_pk_bf16(v0[0], v0[1]); w.y = cvt_pk_bf16(v0[2], v0[3]); w.z = cvt_pk_bf16(v1[0], v1[1]); w.w = cvt_pk_bf16(v1[2], v1[3]); return w; }
__device__ __forceinline__ f32x4 sig4(const f32x4 v) { f32x4 r; r.x = __builtin_amdgcn_rcpf(1.0f + __builtin_amdgcn_exp2f(-1.4426950408889634f * v.x)); r.y = __builtin_amdgcn_rcpf(1.0f + __builtin_amdgcn_exp2f(-1.4426950408889634f * v.y));
    r.z = __builtin_amdgcn_rcpf(1.0f + __builtin_amdgcn_exp2f(-1.4426950408889634f * v.z)); r.w = __builtin_amdgcn_rcpf(1.0f + __builtin_amdgcn_exp2f(-1.4426950408889634f * v.w)); return r; }
__device__ __forceinline__ void bf8_to_f32(const u32x4 w, f32x4& lo, f32x4& hi) { lo.x = __uint_as_float(w.x << 16); lo.y = __uint_as_float(w.x & 0xffff0000u); lo.z = __uint_as_float(w.y << 16); lo.w = __uint_as_float(w.y & 0xffff0000u);
    hi.x = __uint_as_float(w.z << 16); hi.y = __uint_as_float(w.z & 0xffff0000u); hi.z = __uint_as_float(w.w << 16); hi.w = __uint_as_float(w.w & 0xffff0000u); }
struct EpiZ { static constexpr bool PERM = true;
    unsigned char* ws; bf16* VT;
    __device__ __forceinline__ void operator()(const f32x4 (&acc)[2][2][4][2], const Unit& u, int wr, int wc, int fr, int fq) const {
        const int row0 = u.pm * BM + wr * 64 + fr, cw = wc * 32 + 8 * fq; bf16* QH = (bf16*)(ws + WS_QH);
        if (u.pn < 24) {
            const int part = u.pn >> 3, h0 = (u.pn & 7) * 2;
#pragma unroll
            for (int ai = 0; ai < 2; ++ai)
#pragma unroll
                for (int m = 0; m < 4; ++m) { const int row = row0 + ai * HALF + m * 16;
#pragma unroll
                    for (int bj = 0; bj < 2; ++bj) { const u32x4 w = pack8(acc[ai][bj][m][0], acc[ai][bj][m][1]);
                        *(u32x4*)(QH + (size_t)part * (16u << 20) + ((size_t)(h0 + bj) * S + row) * HD + cw) = w;
                        if (VT != nullptr && part == 2) { const unsigned ww[4] = {w.x, w.y, w.z, w.w};
#pragma unroll
                            for (int e = 0; e < 8; ++e) VT[((size_t)(h0 + bj) * HD + cw + e) * S + row] = (bf16)((ww[e >> 1] >> (16 * (e & 1))) & 0xffffu); } } }
        } else {
            const bool sg = u.pn >= 32; const int ld = u.pn < 32 ? PW : D, ct = u.pn < 32 ? u.pn - 24 : (u.pn < 48 ? u.pn - 32 : u.pn - 48);
            bf16* dst = (bf16*)(ws + (u.pn < 32 ? WS_PP : (u.pn < 48 ? WS_GA : WS_GP)));
#pragma unroll
            for (int ai = 0; ai < 2; ++ai)
#pragma unroll
                for (int m = 0; m < 4; ++m) { bf16* rowp = dst + (size_t)(row0 + ai * HALF + m * 16) * ld + ct * BM + cw;
#pragma unroll
                    for (int bj = 0; bj < 2; ++bj) { f32x4 v0 = acc[ai][bj][m][0], v1 = acc[ai][bj][m][1]; if (sg) { v0 = sig4(v0); v1 = sig4(v1); }
                        *(u32x4*)(rowp + bj * HALF) = pack8(v0, v1); } }
        }
    }
};
struct EpiT { static constexpr bool PERM = false;
    const bf16* GP; float* T;
    __device__ __forceinline__ void operator()(const f32x4 (&acc)[2][2][4][2], const Unit& u, int wr, int wc, int fr, int fq) const {
        const int row0 = u.pm * BM + wr * 64 + fr, col0 = u.pn * BM + wc * 32 + 4 * fq;
#pragma unroll
        for (int ai = 0; ai < 2; ++ai)
#pragma unroll
            for (int m = 0; m < 4; ++m) { const size_t off = (size_t)(row0 + ai * HALF + m * 16) * D + col0;
#pragma unroll
                for (int bj = 0; bj < 2; ++bj)
#pragma unroll
                    for (int n = 0; n < 2; ++n) { const u32x2 gw = *(const u32x2*)(GP + off + bj * HALF + n * 16); f32x4 gv; gv.x = __uint_as_float(gw.x << 16); gv.y = __uint_as_float(gw.x & 0xffff0000u); gv.z = __uint_as_float(gw.y << 16); gv.w = __uint_as_float(gw.y & 0xffff0000u);
                        *(f32x4*)(T + off + bj * HALF + n * 16) = acc[ai][bj][m][n] * gv; } }
    }
};
struct EpiM { static constexpr bool PERM = true;
    const bf16* GA; const float* T; bf16* MX;
    __device__ __forceinline__ void operator()(const f32x4 (&acc)[2][2][4][2], const Unit& u, int wr, int wc, int fr, int fq) const {
        const int row0 = u.pm * BM + wr * 64 + fr, col0 = u.pn * BM + wc * 32 + 8 * fq;
#pragma unroll
        for (int ai = 0; ai < 2; ++ai)
#pragma unroll
            for (int m = 0; m < 4; ++m) { const size_t off = (size_t)(row0 + ai * HALF + m * 16) * D + col0;
#pragma unroll
                for (int bj = 0; bj < 2; ++bj) { f32x4 g0, g1; bf8_to_f32(*(const u32x4*)(GA + off + bj * HALF), g0, g1);
                    const f32x4 t0 = *(const f32x4*)(T + off + bj * HALF), t1 = *(const f32x4*)(T + off + bj * HALF + 4);
                    *(u32x4*)(MX + off + bj * HALF) = pack8(acc[ai][bj][m][0] * g0 + t0, acc[ai][bj][m][1] * g1 + t1); } }
    }
};
struct EpiY { static constexpr bool PERM = false;
    const float* base; const float* gate; float* Y;
    __device__ __forceinline__ void operator()(const f32x4 (&acc)[2][2][4][2], const Unit& u, int wr, int wc, int fr, int fq) const {
        const int row0 = u.pm * BM + wr * 64 + fr, col0 = u.pn * BM + wc * 32 + 4 * fq;
        f32x4 gv[2][2];
#pragma unroll
        for (int bj = 0; bj < 2; ++bj)
#pragma unroll
            for (int n = 0; n < 2; ++n) gv[bj][n] = *(const f32x4*)(gate + col0 + bj * HALF + n * 16);
#pragma unroll
        for (int ai = 0; ai < 2; ++ai)
#pragma unroll
            for (int m = 0; m < 4; ++m) { const size_t off = (size_t)(row0 + ai * HALF + m * 16) * D + col0;
#pragma unroll
                for (int bj = 0; bj < 2; ++bj)
#pragma unroll
                    for (int n = 0; n < 2; ++n) { const f32x4 bs = *(const f32x4*)(base + off + bj * HALF + n * 16);
                        *(f32x4*)(Y + off + bj * HALF + n * 16) = bs * ALPHA + acc[ai][bj][m][n] * gv[bj][n]; } }
    }
};
struct EpiGU { static constexpr bool PERM = true;
    bf16* ACT;
    __device__ __forceinline__ void operator()(const f32x4 (&acc)[2][2][4][2], const Unit& u, int wr, int wc, int fr, int fq) const {
        const int row0 = u.pm * BM + wr * 64 + fr, j0 = u.pn * HALF + wc * 32 + 8 * fq;
#pragma unroll
        for (int ai = 0; ai < 2; ++ai)
#pragma unroll
            for (int m = 0; m < 4; ++m) { const f32x4 a0 = acc[ai][0][m][0] * sig4(acc[ai][0][m][0]) * acc[ai][1][m][0], a1 = acc[ai][0][m][1] * sig4(acc[ai][0][m][1]) * acc[ai][1][m][1];
                *(u32x4*)(ACT + (size_t)(row0 + ai * HALF + m * 16) * FFN + j0) = pack8(a0, a1); }
    }
};
}

typedef GAS unsigned gu32;
#define RLX_AGENT __ATOMIC_RELAXED, __HIP_MEMORY_SCOPE_AGENT
#define XB_TMO      128
#define XB_XCNT(j)  (256  + 64 * (j))
#define XB_XSUB(j)  (1280 + 64 * (j))
#define XB_XGEN(j)  (2304 + 64 * (j))
#define XB_TOP      3328
#define XB_TOPGEN   3392
#define XCD_BAR_WORDS 3456
#define XB_SPIN_CAP (1u << 18)

__device__ __forceinline__ unsigned xb_ld(unsigned* p)              { return __hip_atomic_load(p, __ATOMIC_RELAXED, __HIP_MEMORY_SCOPE_AGENT); }
__device__ __forceinline__ unsigned xb_add(unsigned* p, unsigned v) { return __hip_atomic_fetch_add(p, v, __ATOMIC_RELAXED, __HIP_MEMORY_SCOPE_AGENT); }
__device__ __forceinline__ unsigned xb_xcc_id() { return (unsigned)__builtin_amdgcn_s_getreg((3 << 11) | 20) & 0xFu; }
#define XB_SPIN(cond, bar) do { unsigned _sp = 0; while (cond) { __builtin_amdgcn_s_sleep(1); \
    if ((++_sp & 255u) == 0u) { if (xb_ld(&(bar)[XB_TMO])) break; if (_sp > XB_SPIN_CAP) { atomicAdd(&(bar)[XB_TMO], 1u); break; } } } } while (0)

struct XcdBarrier {
    unsigned* bar; unsigned x;
    volatile LAS unsigned* st;
};

__device__ __forceinline__ XcdBarrier xcd_barrier_post(unsigned* bar, volatile LAS unsigned* st) {
    XcdBarrier b; b.bar = bar; b.x = xb_xcc_id(); b.st = st;
    if (threadIdx.x == 0) (void)xb_add(&bar[XB_XCNT(b.x)], 1u);
    return b;
}
__device__ __forceinline__ void xcd_barrier_complete(unsigned* bar, unsigned x, unsigned& nloc, unsigned& nx) {
    const unsigned G = gridDim.x * gridDim.y * gridDim.z;
    unsigned sum, cnt, mine, sp = 0u;
    for (;;) {
        sum = 0u; cnt = 0u; mine = 0u;
#pragma unroll
        for (unsigned j = 0; j < 16; ++j) { const unsigned c = xb_ld(&bar[XB_XCNT(j)]); sum += c; cnt += (c > 0u) ? 1u : 0u; mine = (j == x) ? c : mine; }
        if (sum == G) break;
        __builtin_amdgcn_s_sleep(1);
        if ((++sp & 255u) == 0u) { if (xb_ld(&bar[XB_TMO])) break; if (sp > XB_SPIN_CAP) { atomicAdd(&bar[XB_TMO], 1u); break; } }
    }
    nloc = mine > 0u ? mine : 1u; nx = cnt > 0u ? cnt : 1u;
}

__device__ __forceinline__ void xcd_barrier(const XcdBarrier& b) {
    asm volatile("s_waitcnt vmcnt(0)" ::: "memory");
    __syncthreads();
    if (threadIdx.x == 0) {
        unsigned* bar = b.bar;
        __builtin_amdgcn_s_waitcnt(0);
        unsigned nloc = b.st[0], nx = b.st[1];
        if (nloc == 0u) { xcd_barrier_complete(bar, b.x, nloc, nx); b.st[0] = nloc; b.st[1] = nx; }
        const unsigned old = xb_add(&bar[XB_XSUB(b.x)], 1u);
        const unsigned gen = old / nloc;
        if (old + 1u == (gen + 1u) * nloc) {
            __builtin_amdgcn_fence(__ATOMIC_RELEASE, "agent");
            asm volatile("s_waitcnt vmcnt(0)" ::: "memory");
            const unsigned og = xb_add(&bar[XB_TOP], 1u);
            const unsigned tg = og / nx;
            if (og + 1u == (tg + 1u) * nx) xb_add(&bar[XB_TOPGEN], 1u);
            else XB_SPIN(xb_ld(&bar[XB_TOPGEN]) == tg, bar);
            __builtin_amdgcn_fence(__ATOMIC_ACQUIRE, "agent");
            xb_add(&bar[XB_XGEN(b.x)], 1u);
            asm volatile("s_waitcnt vmcnt(0)" ::: "memory");
        } else {
            XB_SPIN(xb_ld(&bar[XB_XGEN(b.x)]) == gen, bar);
            __builtin_amdgcn_fence(__ATOMIC_ACQUIRE, "agent");
            asm volatile("s_waitcnt vmcnt(0)" ::: "memory");
        }
    }
    __syncthreads();
}


struct Args { const float* in[16]; float* out; unsigned char* ws; int ph_lo, ph_hi; };
constexpr int N_PHASES = 12;
#ifndef FAST_MASK_V
#define FAST_MASK_V 63
#endif
constexpr int FAST_MASK = FAST_MASK_V;
constexpr bool SIMPLE_ATTN = true;

__global__ void __launch_bounds__(NTHREADS, 2) fwd_kernel(Args args) {
    extern __shared__ __attribute__((aligned(16))) unsigned char lds[];
    Ctx C;
    C.lds = (LAS unsigned char*)lds; C.tid = threadIdx.x; C.lane = C.tid & 63; C.wave = __builtin_amdgcn_readfirstlane(C.tid >> 6); C.G = gridDim.x;
    C.x = args.in[0]; C.c = args.in[1]; C.w_ada = args.in[2]; C.b_ada = args.in[3]; C.w_in = args.in[4]; C.b_forget = args.in[5]; C.w_attn_out = args.in[6]; C.w_pool = args.in[7];
    C.pool_scale = args.in[8]; C.w_out = args.in[9]; C.ln1_g = args.in[10]; C.ln1_b = args.in[11]; C.w_gate_up = args.in[12]; C.w_down = args.in[13]; C.ln2_g = args.in[14]; C.ln2_b = args.in[15];
    C.out = args.out; C.ws = args.ws;
    const int lo = args.ph_lo, hi = args.ph_hi;
    volatile LAS unsigned* MISC = (volatile LAS unsigned*)(C.lds + MISC_OFF);
    for (int u = C.tid; u < 32; u += NTHREADS) MISC[u] = 0u;
    __syncthreads();
    XcdBarrier bar = xcd_barrier_post((unsigned*)(C.ws + WS_CTL) + CW_BAR, MISC + 8);
#define IN(k) (lo <= (k) && (k) < hi)
#define SEAM(k) do { if (IN(k) && IN((k) + 1)) xcd_barrier(bar); } while (0)
    if (IN(0)) ph_prologue(C);
    SEAM(0);
    if (IN(1)) ph_ln1(C);
    SEAM(1);
    if (IN(2)) { ph_flogit(C); __syncthreads();
        if constexpr (FAST_MASK & 1) { pg8::Gemm g{WSP(bf16, WS_U), WSP(bf16, WS_WZ), S, NZ, D, D, 1 << 20, 0}; pg8::StaticOrder So; So.init(S, NZ, C.G, (int)blockIdx.x);
            pg8::EpiZ E{C.ws, SIMPLE_ATTN ? WSP(bf16, WS_VT) : (bf16*)nullptr};
            pg8::gemm_phase<pg8::EpiZ, pg8::StaticOrder, true, true>(C.lds, g, So, E); }
        else { EZs E{WSP(bf16, WS_QH), WSP(bf16, WS_VT), WSP(bf16, WS_PP), WSP(bf16, WS_GA), WSP(bf16, WS_GP)};
            sgemm_phase<false>(C, WSP(bf16, WS_U), D, WSP(bf16, WS_WZ), D, S, NZ, D, 1 << 30, 0, E); } }
    SEAM(2);
    if (IN(3)) ph_scan_pool(C);
    SEAM(3);
    if (IN(4)) ph_attn_simple(C);
    SEAM(4);
    if (IN(5)) {
        if constexpr (FAST_MASK & 2) { pg8::Gemm g{WSP(bf16, WS_PL), WSP(bf16, WS_WP), S, D, 512, PW, 4, 512}; pg8::StaticOrder So; So.init(S, D, C.G, (int)blockIdx.x);
            pg8::EpiT E{WSP(bf16, WS_GP), WSP(float, WS_T)}; pg8::gemm_phase<pg8::EpiT, pg8::StaticOrder, true, true>(C.lds, g, So, E); }
        else { ETs E{WSP(bf16, WS_GP), WSP(float, WS_T)}; sgemm_phase<false>(C, WSP(bf16, WS_PL), PW, WSP(bf16, WS_WP), 512, S, D, 512, 1024, 512, E); } }
    SEAM(5);
    if (IN(6)) {
        if constexpr (FAST_MASK & 4) { pg8::Gemm g{WSP(bf16, WS_AO), WSP(bf16, WS_WA), S, D, FW, FW, 1 << 20, 0}; pg8::StaticOrder So; So.init(S, D, C.G, (int)blockIdx.x);
            pg8::EpiM E{WSP(bf16, WS_GA), WSP(float, WS_T), WSP(bf16, WS_MX)}; pg8::gemm_phase<pg8::EpiM, pg8::StaticOrder, true, true>(C.lds, g, So, E); }
        else { EMs E{WSP(bf16, WS_GA), WSP(float, WS_T), WSP(bf16, WS_MX)}; sgemm_phase<false>(C, WSP(bf16, WS_AO), FW, WSP(bf16, WS_WA), FW, S, D, FW, 1 << 30, 0, E); } }
    SEAM(6);
    if (IN(7)) {
        if constexpr (FAST_MASK & 8) { pg8::Gemm g{WSP(bf16, WS_MX), WSP(bf16, WS_WO), S, D, D, D, 1 << 20, 0}; pg8::StaticOrder So; So.init(S, D, C.G, (int)blockIdx.x);
            pg8::EpiY E{C.x, WSP(float, WS_MOD) + 2 * D, WSP(float, WS_Y)}; pg8::gemm_phase<pg8::EpiY, pg8::StaticOrder, true, true>(C.lds, g, So, E); }
        else { EYs E{C.x, WSP(float, WS_MOD) + 2 * D, WSP(float, WS_Y)}; sgemm_phase<false>(C, WSP(bf16, WS_MX), D, WSP(bf16, WS_WO), D, S, D, D, 1 << 30, 0, E); } }
    SEAM(7);
    if (IN(8)) ph_ln_mid(C);
    SEAM(8);
    if (IN(9)) {
        if constexpr (FAST_MASK & 16) { pg8::Gemm g{WSP(bf16, WS_U), WSP(bf16, WS_WGU), S, NGU, D, D, 1 << 20, 0}; pg8::StaticOrder So; So.init(S, NGU, C.G, (int)blockIdx.x);
            pg8::EpiGU E{WSP(bf16, WS_ACT)}; pg8::gemm_phase<pg8::EpiGU, pg8::StaticOrder, true, true>(C.lds, g, So, E); }
        else { EGUs E{WSP(bf16, WS_ACT)}; sgemm_phase<true>(C, WSP(bf16, WS_U), D, WSP(bf16, WS_WGU), D, S, NGU, D, 1 << 30, 0, E); } }
    SEAM(9);
    if (IN(10)) {
        if constexpr (FAST_MASK & 32) { pg8::Gemm g{WSP(bf16, WS_ACT), WSP(bf16, WS_WD), S, D, FFN, FFN, 1 << 20, 0}; pg8::StaticOrder So; So.init(S, D, C.G, (int)blockIdx.x);
            pg8::EpiY E{WSP(float, WS_X1), WSP(float, WS_MOD) + 5 * D, WSP(float, WS_Y)}; pg8::gemm_phase<pg8::EpiY, pg8::StaticOrder, true, true>(C.lds, g, So, E); }
        else { EYs E{WSP(float, WS_X1), WSP(float, WS_MOD) + 5 * D, WSP(float, WS_Y)}; sgemm_phase<false>(C, WSP(bf16, WS_ACT), FFN, WSP(bf16, WS_WD), FFN, S, D, FFN, 1 << 30, 0, E); } }
    SEAM(10);
    if (IN(11)) ph_ln_final(C);
#undef SEAM
#undef IN
}

extern "C" void kernel_launch(void* const* d_in, const int* in_sizes, int n_in, void* d_out, int out_size, void* d_ws, size_t ws_size, hipStream_t stream) {
    static int grid = 0;
    if (grid == 0) {
        if (n_in != 16 || in_sizes[0] != S * D || out_size != S * D || ws_size < WS_END) { fprintf(stderr, "kernel_launch: unexpected shapes (n_in %d, in0 %d, out %d, ws %zu < %zu)\n", n_in, n_in > 0 ? in_sizes[0] : -1, out_size, ws_size, (size_t)WS_END); grid = -1; return; }
        int dev = 0, cus = 0;
        if (hipGetDevice(&dev) != hipSuccess || hipDeviceGetAttribute(&cus, hipDeviceAttributeMultiprocessorCount, dev) != hipSuccess || cus <= 0) cus = 256;
        if (hipFuncSetAttribute((const void*)fwd_kernel, hipFuncAttributeMaxDynamicSharedMemorySize, LDS_BYTES) != hipSuccess) { fprintf(stderr, "kernel_launch: hipFuncSetAttribute failed\n"); grid = -1; return; }
        grid = cus;
    }
    if (grid < 0) return;
    Args a{};
    for (int i = 0; i < 16; ++i) a.in[i] = (const float*)d_in[i];
    a.out = (float*)d_out; a.ws = (unsigned char*)d_ws;
    if (hipMemsetAsync((char*)d_ws + WS_CTL, 0, CTL_ZERO_BYTES, stream) != hipSuccess) { fprintf(stderr, "kernel_launch: memset failed\n"); return; }
    a.ph_lo = 0; a.ph_hi = N_PHASES;
    hipLaunchKernelGGL(fwd_kernel, dim3(grid), dim3(NTHREADS), LDS_BYTES, stream, a);
}
```

```cpp
#include <hip/hip_runtime.h>
#include <cstdio>
#include <cstdint>

#define GAS __attribute__((address_space(1)))
#define LAS __attribute__((address_space(3)))
typedef unsigned short bf16;
typedef short bf16x8 __attribute__((ext_vector_type(8)));
typedef short s16x4 __attribute__((ext_vector_type(4)));
typedef float f32x4 __attribute__((ext_vector_type(4)));
typedef float f32x16 __attribute__((ext_vector_type(16)));
typedef unsigned u32x4 __attribute__((ext_vector_type(4)));
typedef unsigned u32x2 __attribute__((ext_vector_type(2)));

constexpr int S = 8192, D = 4096, NH = 16, HD = 128, FW = 2048, PW = 2048, FFN = 11008, INC = 16400, D6 = 6 * D;
constexpr int NZ = 16384;
constexpr int NGU = 2 * FFN;
constexpr float LN_EPS = 1e-5f;
constexpr float ALPHA = 1.189207115002721f;
constexpr float ATT_SCALE = 0.08838834764831845f;
constexpr float INV_ATT_SCALE = 11.313708498984761f;
constexpr int NWAVES = 8, NTHREADS = 512;

constexpr size_t MiB = 1u << 20;
constexpr size_t WS_CTL = 0;
constexpr size_t WS_MODP = 1 * MiB;
constexpr size_t WS_MOD = 2 * MiB;
constexpr size_t WS_FL = 3 * MiB;
constexpr size_t WS_BK = 4 * MiB;
constexpr size_t WS_WF = 5 * MiB;
constexpr size_t WS_WZ = 8 * MiB;
constexpr size_t WS_WA = WS_WZ + 128 * MiB;
constexpr size_t WS_WP = WS_WA + 16 * MiB;
constexpr size_t WS_WO = WS_WP + 4 * MiB;
constexpr size_t WS_WGU = WS_WO + 32 * MiB;
constexpr size_t WS_WD = WS_WGU + 172 * MiB;
constexpr size_t WS_U = WS_WD + 86 * MiB;
constexpr size_t WS_QH = WS_U + 64 * MiB;
constexpr size_t WS_KH = WS_QH + 32 * MiB;
constexpr size_t WS_VH = WS_KH + 32 * MiB;
constexpr size_t WS_VT = WS_VH + 32 * MiB;
constexpr size_t WS_PP = WS_VT + 32 * MiB;
constexpr size_t WS_GA = WS_PP + 32 * MiB;
constexpr size_t WS_GP = WS_GA + 64 * MiB;
constexpr size_t WS_ACT = WS_QH;
constexpr size_t WS_PL = WS_GP + 64 * MiB;
constexpr size_t WS_AO = WS_PL + 32 * MiB;
constexpr size_t WS_T = WS_AO + 32 * MiB;
constexpr size_t WS_MX = WS_T + 128 * MiB;
constexpr size_t WS_Y = WS_MX + 64 * MiB;
constexpr size_t WS_X1 = WS_Y + 128 * MiB;
constexpr size_t WS_END = WS_X1 + 128 * MiB;
static_assert(WS_QH + 172 * MiB <= WS_GP && WS_KH == WS_QH + 32 * MiB && WS_VH == WS_KH + 32 * MiB, "ACT overlay / QKV contiguity");

constexpr int LDS_BYTES = 147456;
constexpr int MISC_OFF = 131072 + 320;
constexpr int CW_BAR = 4096;
constexpr size_t CTL_ZERO_BYTES = 1u << 20;

__device__ __forceinline__ unsigned cvt_pk_bf16(float lo, float hi) { unsigned r; asm volatile("v_cvt_pk_bf16_f32 %0, %1, %2" : "=v"(r) : "v"(lo), "v"(hi)); return r; }
__device__ __forceinline__ bf16 f2bf(float f) { return (bf16)(cvt_pk_bf16(f, 0.f) & 0xffffu); }
__device__ __forceinline__ float bf2f(bf16 b) { return __uint_as_float(((unsigned)b) << 16); }
__device__ __forceinline__ float wave_sum(float v) {
#pragma unroll
    for (int o = 1; o < 64; o <<= 1) v += __shfl_xor(v, o);
    return v;
}
__device__ __forceinline__ float sigmoidf_(float x) { return 1.0f / (1.0f + __expf(-x)); }
#define LDS_WAIT() asm volatile("s_waitcnt lgkmcnt(0)" ::: "memory")
#define VM_WAIT() asm volatile("s_waitcnt vmcnt(0)" ::: "memory")

struct Ctx {
    LAS unsigned char* lds;
    int tid, lane, wave, G;
    const float *x, *c, *w_ada, *b_ada, *w_in, *b_forget, *w_attn_out, *w_pool, *pool_scale, *w_out, *ln1_g, *ln1_b, *w_gate_up, *w_down, *ln2_g, *ln2_b;
    float* out;
    unsigned char* ws;
};
#define WSP(T, off) ((T*)(C.ws + (off)))

__device__ __forceinline__ void conv_item(const float* W, int ldw, int k0, int srcn0, bf16* dst, int ldd, int dstr0, const float* rscale, LAS float* scr, int lane) {
#pragma unroll 8
    for (int i = 0; i < 32; ++i) { const int kk = 2 * i + (lane >> 5); scr[kk * 33 + (lane & 31)] = W[(size_t)(k0 + kk) * ldw + srcn0 + (lane & 31)]; }
    LDS_WAIT(); asm volatile("" ::: "memory");
    const int c = lane & 7;
#pragma unroll
    for (int j = 0; j < 4; ++j) { const int n = (lane >> 3) + 8 * j; const LAS float* s = scr + (8 * c) * 33 + n;
        const float sc = rscale ? rscale[dstr0 + n] : 1.0f;
        u32x4 o; o.x = cvt_pk_bf16(s[0 * 33] * sc, s[1 * 33] * sc); o.y = cvt_pk_bf16(s[2 * 33] * sc, s[3 * 33] * sc); o.z = cvt_pk_bf16(s[4 * 33] * sc, s[5 * 33] * sc); o.w = cvt_pk_bf16(s[6 * 33] * sc, s[7 * 33] * sc);
        *(u32x4*)(dst + (size_t)(dstr0 + n) * ldd + k0 + 8 * c) = o; }
    LDS_WAIT(); asm volatile("" ::: "memory");
}

__device__ __forceinline__ void ph_prologue(Ctx& C) {
    {
        LAS float* sl = (LAS float*)C.lds;
        LAS float* red = sl + 512;
        float* modp = WSP(float, WS_MODP);
        for (int task = blockIdx.x; task < 256; task += C.G) {
            const int kg = task >> 5, cs = task & 31;
            { const float cv = C.c[512 * kg + C.tid]; sl[C.tid] = cv / (1.0f + __expf(-cv)); }
            __syncthreads();
            f32x4 acc[3] = {};
            const f32x4* wrow = (const f32x4*)(C.w_ada + (size_t)(512 * kg + 64 * C.wave) * D6) + cs * 192 + C.lane;
#pragma unroll 4
            for (int r = 0; r < 64; ++r) { const float s = sl[64 * C.wave + r];
#pragma unroll
                for (int q = 0; q < 3; ++q) { const f32x4 v = wrow[(size_t)r * (D6 / 4) + 64 * q]; acc[q] += v * s; } }
#pragma unroll
            for (int q = 0; q < 3; ++q) *(LAS f32x4*)(red + C.wave * 768 + (C.lane + 64 * q) * 4) = acc[q];
            __syncthreads();
            if (C.tid < 192) { f32x4 s = {0.f, 0.f, 0.f, 0.f};
#pragma unroll
                for (int w = 0; w < 8; ++w) s += *(LAS f32x4*)(red + w * 768 + C.tid * 4);
                *(f32x4*)(modp + (size_t)kg * D6 + cs * 768 + C.tid * 4) = s; }
            __syncthreads();
        }
    }
    {
        LAS float* scr = (LAS float*)(C.lds + C.wave * 16384);
        const int gw = blockIdx.x * NWAVES + C.wave, NGW = C.G * NWAVES;
        constexpr int I_ZA = 64 * 192, I_ZB = 64 * 320, I_A = 32 * 128, I_P = 4 * 8 * 32, I_O = 64 * 128, I_GU = 64 * 688, I_D = 172 * 128;
        constexpr int NITEMS = I_ZA + I_ZB + I_A + I_P + I_O + I_GU + I_D;
        for (int it = gw; it < NITEMS; it += NGW) {
            int r = it;
            if (r < I_GU) { const int kb = r / 688, nb = r % 688, r0 = 32 * nb, tile = r0 >> 8, within = r0 & 255, half = within >> 7, j0 = tile * 128 + (within & 127);
                conv_item(C.w_gate_up, NGU, 64 * kb, half * FFN + j0, WSP(bf16, WS_WGU), D, r0, nullptr, scr, C.lane); continue; } r -= I_GU;
            if (r < I_D) { const int kb = r / 128, nb = r % 128; conv_item(C.w_down, D, 64 * kb, 32 * nb, WSP(bf16, WS_WD), FFN, 32 * nb, nullptr, scr, C.lane); continue; } r -= I_D;
            if (r < I_O) { const int kb = r / 128, nb = r % 128; conv_item(C.w_out, D, 64 * kb, 32 * nb, WSP(bf16, WS_WO), D, 32 * nb, nullptr, scr, C.lane); continue; } r -= I_O;
            if (r < I_A) { const int kb = r / 128, nb = r % 128; conv_item(C.w_attn_out, D, 64 * kb, 32 * nb, WSP(bf16, WS_WA), FW, 32 * nb, nullptr, scr, C.lane); continue; } r -= I_A;
            if (r < I_P) { const int g = r / 256, rr = r % 256, kb = rr / 32, nb = rr % 32;
                conv_item(C.w_pool + (size_t)g * 512 * 1024, 1024, 64 * kb, 32 * nb, WSP(bf16, WS_WP), 512, 1024 * g + 32 * nb, C.pool_scale, scr, C.lane); continue; } r -= I_P;
            if (r < I_ZA) { const int kb = r / 192, nb = r % 192; conv_item(C.w_in, INC, 64 * kb, 32 * nb, WSP(bf16, WS_WZ), D, 32 * nb, nullptr, scr, C.lane); continue; } r -= I_ZA;
            { const int kb = r / 320, nb = r % 320; conv_item(C.w_in, INC, 64 * kb, 6160 + 32 * nb, WSP(bf16, WS_WZ), D, 6144 + 32 * nb, nullptr, scr, C.lane); }
        }
        bf16* wf = WSP(bf16, WS_WF);
        for (int g = blockIdx.x * NTHREADS + C.tid; g < 16 * D; g += C.G * NTHREADS) { const int h = g & 15, k = g >> 4; wf[h * D + k] = f2bf(C.w_in[(size_t)k * INC + 6144 + h]); }
    }
}

__device__ __forceinline__ void row_load(const float* rowp, int lane, f32x4 (&v)[16]) {
    const f32x4* p = (const f32x4*)rowp + lane;
#pragma unroll
    for (int j = 0; j < 16; ++j) v[j] = p[64 * j];
}
__device__ __forceinline__ void row_normalize(f32x4 (&v)[16]) {
    float s = 0.f;
#pragma unroll
    for (int j = 0; j < 16; ++j) s += (v[j].x + v[j].y) + (v[j].z + v[j].w);
    const float mean = wave_sum(s) * (1.0f / D); float s2 = 0.f;
#pragma unroll
    for (int j = 0; j < 16; ++j) { v[j] = v[j] - mean; s2 += (v[j].x * v[j].x + v[j].y * v[j].y) + (v[j].z * v[j].z + v[j].w * v[j].w); }
    const float rstd = 1.0f / sqrtf(wave_sum(s2) * (1.0f / D) + LN_EPS);
#pragma unroll
    for (int j = 0; j < 16; ++j) v[j] = v[j] * rstd;
}
__device__ __forceinline__ void mod_to_lds(Ctx& C, LAS float* dst, int chunk, float add) {
    const float* modp = WSP(float, WS_MODP);
    for (int c = C.tid; c < D; c += NTHREADS) { float s = C.b_ada[chunk * D + c];
#pragma unroll
        for (int kg = 0; kg < 8; ++kg) s += modp[(size_t)kg * D6 + chunk * D + c];
        dst[c] = s + add; }
}

__device__ __forceinline__ void ph_ln1(Ctx& C) {
    LAS float* sc = (LAS float*)C.lds; LAS float* sh = sc + D;
    mod_to_lds(C, sh, 0, 0.f); mod_to_lds(C, sc, 1, 1.f);
    { const float* modp = WSP(float, WS_MODP); float* mod = WSP(float, WS_MOD);
      for (int j = blockIdx.x * NTHREADS + C.tid; j < D6; j += C.G * NTHREADS) { float s = C.b_ada[j];
#pragma unroll
          for (int kg = 0; kg < 8; ++kg) s += modp[(size_t)kg * D6 + j];
          mod[j] = s; } }
    __syncthreads();
    bf16* U = WSP(bf16, WS_U);
    for (int row = blockIdx.x * NWAVES + C.wave; row < S; row += C.G * NWAVES) {
        f32x4 v[16]; row_load(C.x + (size_t)row * D, C.lane, v); row_normalize(v);
        u32x2* o = (u32x2*)(U + (size_t)row * D) + C.lane;
#pragma unroll
        for (int j = 0; j < 16; ++j) { const f32x4 a = *(LAS f32x4*)(sc + 4 * (C.lane + 64 * j)), b = *(LAS f32x4*)(sh + 4 * (C.lane + 64 * j)); const f32x4 r = v[j] * a + b;
            u32x2 w; w.x = cvt_pk_bf16(r.x, r.y); w.y = cvt_pk_bf16(r.z, r.w); o[64 * j] = w; }
    }
}
__device__ __forceinline__ void ph_ln_mid(Ctx& C) {
    LAS float* g = (LAS float*)C.lds; LAS float* b = g + D; LAS float* sc = b + D; LAS float* sh = sc + D;
    const float* mod = WSP(float, WS_MOD);
    for (int c = C.tid; c < D; c += NTHREADS) { g[c] = C.ln1_g[c]; b[c] = C.ln1_b[c]; sh[c] = mod[3 * D + c]; sc[c] = 1.0f + mod[4 * D + c]; }
    __syncthreads();
    bf16* U = WSP(bf16, WS_U); const float* Y = WSP(float, WS_Y); float* X1 = WSP(float, WS_X1);
    for (int row = blockIdx.x * NWAVES + C.wave; row < S; row += C.G * NWAVES) {
        f32x4 v[16]; row_load(Y + (size_t)row * D, C.lane, v); row_normalize(v);
        f32x4* xo = (f32x4*)(X1 + (size_t)row * D) + C.lane;
#pragma unroll
        for (int j = 0; j < 16; ++j) { const f32x4 a = *(LAS f32x4*)(g + 4 * (C.lane + 64 * j)), bb = *(LAS f32x4*)(b + 4 * (C.lane + 64 * j)); v[j] = v[j] * a + bb; xo[64 * j] = v[j]; }
        row_normalize(v);
        u32x2* o = (u32x2*)(U + (size_t)row * D) + C.lane;
#pragma unroll
        for (int j = 0; j < 16; ++j) { const f32x4 a = *(LAS f32x4*)(sc + 4 * (C.lane + 64 * j)), bb = *(LAS f32x4*)(sh + 4 * (C.lane + 64 * j)); const f32x4 r = v[j] * a + bb;
            u32x2 w; w.x = cvt_pk_bf16(r.x, r.y); w.y = cvt_pk_bf16(r.z, r.w); o[64 * j] = w; }
    }
}
__device__ __forceinline__ void ph_ln_final(Ctx& C) {
    LAS float* g = (LAS float*)C.lds; LAS float* b = g + D;
    for (int c = C.tid; c < D; c += NTHREADS) { g[c] = C.ln2_g[c]; b[c] = C.ln2_b[c]; }
    __syncthreads();
    const float* Y = WSP(float, WS_Y);
    for (int row = blockIdx.x * NWAVES + C.wave; row < S; row += C.G * NWAVES) {
        f32x4 v[16]; row_load(Y + (size_t)row * D, C.lane, v); row_normalize(v);
        f32x4* xo = (f32x4*)(C.out + (size_t)row * D) + C.lane;
#pragma unroll
        for (int j = 0; j < 16; ++j) { const f32x4 a = *(LAS f32x4*)(g + 4 * (C.lane + 64 * j)), bb = *(LAS f32x4*)(b + 4 * (C.lane + 64 * j)); xo[64 * j] = v[j] * a + bb; }
    }
}

__device__ __forceinline__ void ph_flogit(Ctx& C) {
    const bf16* U = WSP(bf16, WS_U); const bf16* WF = WSP(bf16, WS_WF); float* FL = WSP(float, WS_FL);
    LAS float* red = (LAS float*)C.lds;
    const int fr = C.lane & 15, fq = C.lane >> 4, rg = C.wave >> 2, kq = C.wave & 3;
    for (int blk = blockIdx.x; blk < S / 32; blk += C.G) {
        const int row = 32 * blk + 16 * rg + fr;
        const bf16* ap = U + (size_t)row * D + 1024 * kq + 8 * fq; const bf16* bp = WF + (size_t)fr * D + 1024 * kq + 8 * fq;
        f32x4 acc = {0.f, 0.f, 0.f, 0.f};
#pragma unroll 8
        for (int k = 0; k < 32; ++k) { const bf16x8 a = *(const bf16x8*)(ap + 32 * k), b = *(const bf16x8*)(bp + 32 * k); acc = __builtin_amdgcn_mfma_f32_16x16x32_bf16(a, b, acc, 0, 0, 0); }
        *(LAS f32x4*)(red + C.wave * 256 + C.lane * 4) = acc;
        __syncthreads();
        if (kq == 0) { f32x4 s = acc;
#pragma unroll
            for (int w = 1; w < 4; ++w) s += *(LAS f32x4*)(red + (C.wave + w) * 256 + C.lane * 4);
            s += C.b_forget[fr];
            *(f32x4*)(FL + (size_t)fr * S + 32 * blk + 16 * rg + 4 * fq) = s; }
        __syncthreads();
    }
}

__device__ __forceinline__ void ph_scan_pool(Ctx& C) {
    LAS float* wsum = (LAS float*)C.lds;
    for (int h = blockIdx.x; h < NH; h += C.G) {
        const float* fl = WSP(float, WS_FL) + (size_t)h * S; float* bk = WSP(float, WS_BK) + (size_t)h * S;
        float v[16];
#pragma unroll
        for (int q = 0; q < 4; ++q) { const f32x4 t = *(const f32x4*)(fl + 16 * C.tid + 4 * q); v[4 * q] = t.x; v[4 * q + 1] = t.y; v[4 * q + 2] = t.z; v[4 * q + 3] = t.w; }
        float run = 0.f;
#pragma unroll
        for (int i = 0; i < 16; ++i) { const float xx = v[i]; const float ls = -(fmaxf(-xx, 0.f) + log1pf(__expf(-fabsf(xx)))); run += ls; v[i] = run; }
        float incl = run;
#pragma unroll
        for (int o = 1; o < 64; o <<= 1) { const float t = __shfl_up(incl, o); if (C.lane >= o) incl += t; }
        if (C.lane == 63) wsum[C.wave] = incl;
        __syncthreads();
        float off = incl - run;
        for (int w = 0; w < C.wave; ++w) off += wsum[w];
#pragma unroll
        for (int q = 0; q < 4; ++q) { f32x4 t; t.x = -(v[4 * q] + off) * INV_ATT_SCALE; t.y = -(v[4 * q + 1] + off) * INV_ATT_SCALE; t.z = -(v[4 * q + 2] + off) * INV_ATT_SCALE; t.w = -(v[4 * q + 3] + off) * INV_ATT_SCALE;
            *(f32x4*)(bk + 16 * C.tid + 4 * q) = t; }
        __syncthreads();
    }
    const bf16* PP = WSP(bf16, WS_PP); bf16* PL = WSP(bf16, WS_PL);
    for (int gt = blockIdx.x * NTHREADS + C.tid; gt < (S / 16) * (PW / 8); gt += C.G * NTHREADS) {
        const int cc = gt & 255, rc = gt >> 8, g = cc >> 6, w = 2 << g, r0 = 16 * rc;
        const bf16* base = PP + 8 * cc; float sum[8] = {0.f, 0.f, 0.f, 0.f, 0.f, 0.f, 0.f, 0.f};
        for (int j = 1; j < w; ++j) { const int r = r0 - j; if (r >= 0) { const bf16x8 t = *(const bf16x8*)(base + (size_t)r * PW);
#pragma unroll
                for (int e = 0; e < 8; ++e) sum[e] += bf2f((bf16)t[e]); } }
        for (int i = 0; i < 16; ++i) { const int r = r0 + i; const bf16x8 t = *(const bf16x8*)(base + (size_t)r * PW);
            const float inv = 1.0f / (float)((r + 1) < w ? (r + 1) : w); float o[8];
#pragma unroll
            for (int e = 0; e < 8; ++e) { const float pv = bf2f((bf16)t[e]); sum[e] += pv; o[e] = sum[e] * inv - pv; }
            u32x4 ow; ow.x = cvt_pk_bf16(o[0], o[1]); ow.y = cvt_pk_bf16(o[2], o[3]); ow.z = cvt_pk_bf16(o[4], o[5]); ow.w = cvt_pk_bf16(o[6], o[7]);
            *(u32x4*)(PL + (size_t)r * PW + 8 * cc) = ow;
            const int ro = r - w + 1; if (ro >= 0) { const bf16x8 t2 = *(const bf16x8*)(base + (size_t)ro * PW);
#pragma unroll
                for (int e = 0; e < 8; ++e) sum[e] -= bf2f((bf16)t2[e]); } }
    }
}

template <bool PAIR, class Epi>
__device__ __forceinline__ void sgemm_phase(Ctx& C, const bf16* A, int lda, const bf16* Bt, int ldb, int M, int N, int K, int grp_cols, int grp_off, const Epi& E) {
    const int fr = C.lane & 15, fq = C.lane >> 4, wm = C.wave >> 2, wn = C.wave & 3;
    const int nTn = N / 256, nT = (M / 128) * nTn;
    for (int t = blockIdx.x; t < nT; t += C.G) {
        const int tm = t / nTn, tn = t % nTn, row0 = tm * 128 + wm * 64;
        const bf16* Ab = A + (size_t)((tn * 256) / grp_cols) * grp_off;
        int brow[4];
#pragma unroll
        for (int j = 0; j < 4; ++j) brow[j] = PAIR ? (tn * 256 + (j >> 1) * 128 + wn * 32 + (j & 1) * 16 + fr) : (tn * 256 + wn * 64 + 16 * j + fr);
        f32x4 acc[4][4];
#pragma unroll
        for (int i = 0; i < 4; ++i)
#pragma unroll
            for (int j = 0; j < 4; ++j) acc[i][j] = (f32x4){0.f, 0.f, 0.f, 0.f};
        for (int k0 = 0; k0 < K; k0 += 32) {
            bf16x8 a[4], b[4];
#pragma unroll
            for (int i = 0; i < 4; ++i) a[i] = *(const bf16x8*)(Ab + (size_t)(row0 + 16 * i + fr) * lda + k0 + 8 * fq);
#pragma unroll
            for (int j = 0; j < 4; ++j) b[j] = *(const bf16x8*)(Bt + (size_t)brow[j] * ldb + k0 + 8 * fq);
#pragma unroll
            for (int i = 0; i < 4; ++i)
#pragma unroll
                for (int j = 0; j < 4; ++j) acc[i][j] = __builtin_amdgcn_mfma_f32_16x16x32_bf16(a[i], b[j], acc[i][j], 0, 0, 0);
        }
        if constexpr (PAIR) {
#pragma unroll
            for (int i = 0; i < 4; ++i)
#pragma unroll
                for (int j = 0; j < 2; ++j)
#pragma unroll
                    for (int e = 0; e < 4; ++e) E(row0 + 16 * i + 4 * fq + e, tn * 128 + wn * 32 + j * 16 + fr, acc[i][j][e], acc[i][j + 2][e]);
        } else {
#pragma unroll
            for (int i = 0; i < 4; ++i)
#pragma unroll
                for (int j = 0; j < 4; ++j)
#pragma unroll
                    for (int e = 0; e < 4; ++e) E(row0 + 16 * i + 4 * fq + e, tn * 256 + wn * 64 + 16 * j + fr, acc[i][j][e]);
        }
    }
}

__device__ __forceinline__ int crow(int r, int hi) { return (r & 3) + 8 * (r >> 2) + 4 * hi; }
__device__ __forceinline__ void ph_attn_simple(Ctx& C) {
    const bf16* QH = WSP(bf16, WS_QH); const bf16* KH = WSP(bf16, WS_KH); const bf16* VT = WSP(bf16, WS_VT); const float* BK = WSP(float, WS_BK); bf16* AO = WSP(bf16, WS_AO);
    LAS float* wl = (LAS float*)C.lds + C.wave * 64;
    const int c32 = C.lane & 31, hi = C.lane >> 5;
    constexpr float C2 = 1.4426950408889634f * ATT_SCALE;
    const int gw = blockIdx.x * NWAVES + C.wave, NGW = C.G * NWAVES;
    for (int u = gw; u < NH * 256; u += NGW) {
        const int h = u & 15, idx = u >> 4, half = idx >> 7, qb = half ? (idx & 127) : 255 - (idx & 127);
        const int q0 = 32 * qb;
        const bf16* Qp = QH + ((size_t)h * S + q0 + c32) * HD + 8 * hi;
        bf16x8 qf[8];
#pragma unroll
        for (int d0 = 0; d0 < 8; ++d0) qf[d0] = *(const bf16x8*)(Qp + 16 * d0);
        f32x16 o[4];
#pragma unroll
        for (int d = 0; d < 4; ++d)
#pragma unroll
            for (int r = 0; r < 16; ++r) o[d][r] = 0.f;
        float m_run = -1e30f, l_run = 0.f;
        for (int jt = 0; jt <= qb; ++jt) {
            const int k0 = 32 * jt;
            f32x16 p;
#pragma unroll
            for (int r = 0; r < 16; ++r) p[r] = 0.f;
            const bf16* Kp = KH + ((size_t)h * S + k0 + c32) * HD + 8 * hi;
#pragma unroll
            for (int d0 = 0; d0 < 8; ++d0) { const bf16x8 kf = *(const bf16x8*)(Kp + 16 * d0); p = __builtin_amdgcn_mfma_f32_32x32x16_bf16(kf, qf[d0], p, 0, 0, 0); }
            float mx = -__builtin_inff();
#pragma unroll
            for (int r = 0; r < 16; ++r) { const int key = k0 + crow(r, hi); float sv = (p[r] + BK[(size_t)h * S + key]) * C2; if (key > q0 + c32) sv = -__builtin_inff(); p[r] = sv; mx = fmaxf(mx, sv); }
            mx = fmaxf(mx, __shfl_xor(mx, 32));
            const float m_new = fmaxf(m_run, mx), alpha = exp2f(m_run - m_new); m_run = m_new;
            float ps = 0.f;
#pragma unroll
            for (int r = 0; r < 16; ++r) { p[r] = exp2f(p[r] - m_new); ps += p[r]; }
            ps += __shfl_xor(ps, 32);
            l_run = l_run * alpha + ps;
            if (hi == 0) wl[c32] = alpha;
            LDS_WAIT(); asm volatile("" ::: "memory");
#pragma unroll
            for (int r = 0; r < 16; ++r) { const float a = wl[crow(r, hi)];
#pragma unroll
                for (int d = 0; d < 4; ++d) o[d][r] *= a; }
            LDS_WAIT(); asm volatile("" ::: "memory");
            bf16x8 pa[2];
#pragma unroll
            for (int ks = 0; ks < 2; ++ks) { u32x4 w; w.x = cvt_pk_bf16(p[8 * ks + 0], p[8 * ks + 1]); w.y = cvt_pk_bf16(p[8 * ks + 2], p[8 * ks + 3]); w.z = cvt_pk_bf16(p[8 * ks + 4], p[8 * ks + 5]); w.w = cvt_pk_bf16(p[8 * ks + 6], p[8 * ks + 7]); pa[ks] = *reinterpret_cast<bf16x8*>(&w); }
#pragma unroll
            for (int d = 0; d < 4; ++d) { const bf16* vp = VT + ((size_t)h * HD + 32 * d + c32) * S + k0 + 4 * hi;
#pragma unroll
                for (int ks = 0; ks < 2; ++ks) { const s16x4 v0 = *(const s16x4*)(vp + 16 * ks), v1 = *(const s16x4*)(vp + 16 * ks + 8);
                    const bf16x8 vb = {v0[0], v0[1], v0[2], v0[3], v1[0], v1[1], v1[2], v1[3]};
                    o[d] = __builtin_amdgcn_mfma_f32_32x32x16_bf16(pa[ks], vb, o[d], 0, 0, 0); } }
        }
        if (hi == 0) wl[c32] = 1.0f / l_run;
        LDS_WAIT(); asm volatile("" ::: "memory");
#pragma unroll
        for (int r = 0; r < 16; ++r) { const int qr = crow(r, hi); const float il = wl[qr];
#pragma unroll
            for (int d = 0; d < 4; ++d) AO[(size_t)(q0 + qr) * FW + h * HD + 32 * d + c32] = f2bf(o[d][r] * il); }
        LDS_WAIT(); asm volatile("" ::: "memory");
    }
}

struct EZs { bf16 *QH, *VT, *PP, *GA, *GP;
    __device__ __forceinline__ void operator()(int row, int col, float v) const {
        if (col < 6144) { const int part = col >> 11, h = (col & 2047) >> 7, d = col & 127; bf16* dst = QH + (size_t)part * (16u << 20); const bf16 b = f2bf(v);
            dst[((size_t)h * S + row) * HD + d] = b; if (part == 2) VT[((size_t)h * HD + d) * S + row] = b; }
        else if (col < 8192) PP[(size_t)row * PW + (col - 6144)] = f2bf(v);
        else if (col < 12288) GA[(size_t)row * D + (col - 8192)] = f2bf(sigmoidf_(v));
        else GP[(size_t)row * D + (col - 12288)] = f2bf(sigmoidf_(v)); } };
struct ETs { const bf16* GP; float* T;
    __device__ __forceinline__ void operator()(int row, int col, float v) const { T[(size_t)row * D + col] = bf2f(GP[(size_t)row * D + col]) * v; } };
struct EMs { const bf16* GA; const float* T; bf16* MX;
    __device__ __forceinline__ void operator()(int row, int col, float v) const { MX[(size_t)row * D + col] = f2bf(bf2f(GA[(size_t)row * D + col]) * v + T[(size_t)row * D + col]); } };
struct EYs { const float* base; const float* gate; float* Y;
    __device__ __forceinline__ void operator()(int row, int col, float v) const { Y[(size_t)row * D + col] = ALPHA * base[(size_t)row * D + col] + gate[col] * v; } };
struct EGUs { bf16* ACT;
    __device__ __forceinline__ void operator()(int row, int j, float g, float up) const { ACT[(size_t)row * FFN + j] = f2bf(g / (1.0f + __expf(-g)) * up); } };

namespace pg8 {
constexpr int BM = 256, BK = 64, HALF = 128, HTB = HALF * BK * 2, STAGE_BYTES = 8 * HTB, NXCD = 8, WGM = 8;
__host__ __device__ __forceinline__ int lds_byte(int r, int c) { const int st = (r >> 4) * 2 + (c >> 5), rr = r & 15, cc = c & 31, ob = rr * 64 + cc * 2; return st * 1024 + (ob ^ (((ob >> 9) & 1) << 5)); }
__host__ __device__ __forceinline__ void stage_rc(int b, int& R, int& C) { const int st = b / 1024, sb = b % 1024, swz = sb ^ (((sb >> 9) & 1) << 5); R = (st >> 1) * 16 + swz / 64; C = (st & 1) * 32 + (swz % 64) / 2; }
__host__ __device__ __forceinline__ int perm32(int rho) { const int n = rho >> 4, i = rho & 15; return 8 * (i >> 2) + 4 * n + (i & 3); }
struct Unit { int pm, pn; };
struct Gemm { const bf16* A; const bf16* Bt; int M, N, K, lda, grp_tiles, grp_off; };
struct StaticOrder {
    int nM, nN, nwg, G, c;
    __host__ __device__ void init(int M, int N, int G_, int c_) { nM = M / BM; nN = N / BM; nwg = nM * nN; G = G_; c = c_; }
    __host__ __device__ bool next(int i, Unit& u) const {
        const long L = (long)i * G + c; if (L >= nwg) return false;
        int wgid = (int)L; { const int q = nwg / NXCD, r = nwg % NXCD, xcd = wgid % NXCD, off = wgid / NXCD; wgid = (xcd < r ? xcd * (q + 1) : r * (q + 1) + (xcd - r) * q) + off; }
        const int nig = WGM * nN, gid = wgid / nig, fm = gid * WGM, gsz = (nM - fm) < WGM ? (nM - fm) : WGM;
        u.pm = fm + ((wgid % nig) % gsz); u.pn = (wgid % nig) / gsz; return true;
    }
    __device__ __forceinline__ void a_ready(const Unit&) const {}
    __device__ __forceinline__ void done(const Unit&) const {}
};
template <class Epi, class Sched, bool ALIGN_EPI = false, bool SP2 = false>
__device__ __forceinline__ void gemm_phase(LAS unsigned char* lds, const Gemm g, const Sched& S, const Epi& E) {
    const int tid = threadIdx.x, wid = __builtin_amdgcn_readfirstlane(tid >> 6), lane = tid & 63, wr = wid >> 2, wc = wid & 3, fr = lane & 15, fq = lane >> 4;
    const int K = g.K, nt = K / BK, lda = g.lda;
    unsigned voffA[2], voffB[2];
#pragma unroll
    for (int i = 0; i < 2; ++i) { int R, Cc; stage_rc(tid * 16 + i * 8192, R, Cc); const int Rb = Epi::PERM ? ((R & ~31) + perm32(R & 31)) : R;
        voffA[i] = (unsigned)(R * lda + Cc) * 2u; voffB[i] = (unsigned)(Rb * K + Cc) * 2u; }
    const size_t kstep = (size_t)(BK * 2);
    const size_t hstepA = (size_t)HALF * lda * 2, hstepB = (size_t)HALF * K * 2;
    const size_t tstepA = 2 * hstepA, tstepB = 2 * hstepB;
    const unsigned ldsw = (unsigned)wid * 1024u;
    const int aoff = lds_byte(wr * 64 + fr, fq * 8), boff = lds_byte(wc * 32 + fr, fq * 8);
#define PG8_SA(b, h) (((b) * 2 + (h)) * HTB)
#define PG8_SB(b, h) ((4 + (b) * 2 + (h)) * HTB)
#define PG8_STAGE(bufoff, gbase, voff) do { _Pragma("unroll") for (int _i = 0; _i < 2; ++_i) \
        __builtin_amdgcn_global_load_lds((const unsigned*)((const char*)(gbase) + (voff)[_i]), (LAS unsigned*)(lds + (bufoff) + ldsw + _i * 8192), 16, 0, 0); } while (0)
#define PG8_LDA(dst, b, h) do { _Pragma("unroll") for (int m = 0; m < 4; ++m) _Pragma("unroll") for (int k = 0; k < 2; ++k) dst[m][k] = *(const LAS bf16x8*)(lds + PG8_SA(b, h) + aoff + m * 2048 + k * 1024); } while (0)
#define PG8_LDB(dst, b, h) do { _Pragma("unroll") for (int n = 0; n < 2; ++n) _Pragma("unroll") for (int k = 0; k < 2; ++k) dst[n][k] = *(const LAS bf16x8*)(lds + PG8_SB(b, h) + boff + n * 2048 + k * 1024); } while (0)
#define PG8_MMA(ai, bj, At, Bt) do { __builtin_amdgcn_s_setprio(1); _Pragma("unroll") for (int m = 0; m < 4; ++m) _Pragma("unroll") for (int n = 0; n < 2; ++n) _Pragma("unroll") for (int k = 0; k < 2; ++k) \
        acc[ai][bj][m][n] = __builtin_amdgcn_mfma_f32_16x16x32_bf16(Bt[n][k], At[m][k], acc[ai][bj][m][n], 0, 0, 0); __builtin_amdgcn_s_setprio(0); } while (0)
#define PG8_WAIT_V(n) asm volatile("s_waitcnt vmcnt(" #n ")" ::: "memory")
#define PG8_WAIT_L(n) asm volatile("s_waitcnt lgkmcnt(" #n ")" ::: "memory")
#define PG8_BAR __builtin_amdgcn_s_barrier()
#define PG8_SCHED __builtin_amdgcn_sched_barrier(0)
#define PG8_ABASE(u) ((const char*)g.A + (size_t)(u).pm * tstepA + (size_t)((u).pn / g.grp_tiles) * g.grp_off * 2)
    Unit cur, nxt; int ui = 0;
    if (!S.next(0, cur)) return;
    f32x4 acc[2][2][4][2];
#pragma unroll
    for (int a = 0; a < 2; ++a)
#pragma unroll
        for (int b = 0; b < 2; ++b)
#pragma unroll
            for (int m = 0; m < 4; ++m)
#pragma unroll
                for (int n = 0; n < 2; ++n) acc[a][b][m][n] = (f32x4){0.f, 0.f, 0.f, 0.f};
    bf16x8 At[4][2], B0[2][2], B1[2][2];
    const char* cA = PG8_ABASE(cur); const char* cB = (const char*)g.Bt + (size_t)cur.pn * tstepB;
    S.a_ready(cur);
    if constexpr (SP2) {
        PG8_STAGE(PG8_SB(0, 0), cB, voffB); PG8_STAGE(PG8_SB(0, 1), cB + hstepB, voffB); PG8_STAGE(PG8_SA(0, 0), cA, voffA); PG8_STAGE(PG8_SA(0, 1), cA + hstepA, voffA);
        if (wr == 1) PG8_BAR;
        PG8_WAIT_V(2); PG8_BAR;
        PG8_STAGE(PG8_SB(1, 0), cB + kstep, voffB); PG8_STAGE(PG8_SA(1, 0), cA + kstep, voffA); PG8_STAGE(PG8_SB(1, 1), cB + hstepB + kstep, voffB);
        PG8_WAIT_V(6); PG8_BAR;
    } else {
        PG8_STAGE(PG8_SB(0, 0), cB, voffB); PG8_STAGE(PG8_SA(0, 0), cA, voffA); PG8_STAGE(PG8_SB(0, 1), cB + hstepB, voffB); PG8_STAGE(PG8_SA(0, 1), cA + hstepA, voffA);
        if (wr == 1) PG8_BAR;
        PG8_WAIT_V(4); PG8_BAR;
        PG8_STAGE(PG8_SB(1, 0), cB + kstep, voffB); PG8_STAGE(PG8_SA(1, 0), cA + kstep, voffA); PG8_STAGE(PG8_SB(1, 1), cB + hstepB + kstep, voffB);
        PG8_WAIT_V(6); PG8_BAR;
    }
    for (;;) {
        const bool has_next = S.next(ui + 1, nxt);
        const char* nA = has_next ? PG8_ABASE(nxt) : cA; const char* nB = has_next ? (const char*)g.Bt + (size_t)nxt.pn * tstepB : cB;
        for (int t = 0; t < nt; t += 2) {
            const bool last = (t == nt - 2);
            const char* a1 = cA + (size_t)(t + 1) * kstep;
            const char* a2 = last ? nA : cA + (size_t)(t + 2) * kstep; const char* b2 = last ? nB : cB + (size_t)(t + 2) * kstep;
            const char* a3 = a2 + kstep; const char* b3 = b2 + kstep;
            if (last && has_next) S.a_ready(nxt);
            if constexpr (SP2) {
            PG8_LDB(B0, 0, 0); PG8_LDB(B1, 0, 1); PG8_SCHED; PG8_LDA(At, 0, 0); PG8_STAGE(PG8_SA(1, 1), a1 + hstepA, voffA);
            PG8_WAIT_V(8); PG8_WAIT_L(0); PG8_BAR; PG8_MMA(0, 0, At, B0); PG8_MMA(0, 1, At, B1); PG8_BAR; PG8_SCHED;
            PG8_LDA(At, 0, 1); PG8_STAGE(PG8_SB(0, 0), b2, voffB); PG8_STAGE(PG8_SB(0, 1), b2 + hstepB, voffB); PG8_STAGE(PG8_SA(0, 0), a2, voffA);
            PG8_WAIT_V(8); PG8_WAIT_L(0); PG8_BAR; PG8_MMA(1, 0, At, B0); PG8_MMA(1, 1, At, B1); PG8_BAR; PG8_SCHED;
            PG8_LDB(B0, 1, 0); PG8_LDB(B1, 1, 1); PG8_SCHED; PG8_LDA(At, 1, 0); PG8_STAGE(PG8_SA(0, 1), a2 + hstepA, voffA);
            PG8_WAIT_V(8); PG8_WAIT_L(0); PG8_BAR; PG8_MMA(0, 0, At, B0); PG8_MMA(0, 1, At, B1); PG8_BAR; PG8_SCHED;
            PG8_LDA(At, 1, 1); PG8_STAGE(PG8_SB(1, 0), b3, voffB); PG8_STAGE(PG8_SB(1, 1), b3 + hstepB, voffB); PG8_STAGE(PG8_SA(1, 0), a3, voffA);
            PG8_WAIT_V(8); PG8_WAIT_L(0); PG8_BAR; PG8_MMA(1, 0, At, B0); PG8_MMA(1, 1, At, B1); PG8_BAR; PG8_SCHED;
            } else {
            PG8_LDB(B0, 0, 0); PG8_SCHED; PG8_LDA(At, 0, 0); PG8_STAGE(PG8_SA(1, 1), a1 + hstepA, voffA);
            PG8_WAIT_L(8); PG8_BAR; PG8_WAIT_L(0); PG8_MMA(0, 0, At, B0); PG8_BAR; PG8_SCHED;
            PG8_LDB(B1, 0, 1); PG8_STAGE(PG8_SB(0, 0), b2, voffB);
            PG8_BAR; PG8_WAIT_L(0); PG8_MMA(0, 1, At, B1); PG8_BAR;
            PG8_LDA(At, 0, 1); PG8_STAGE(PG8_SA(0, 0), a2, voffA);
            PG8_BAR; PG8_WAIT_L(0); PG8_MMA(1, 0, At, B0); PG8_BAR; PG8_SCHED;
            PG8_STAGE(PG8_SB(0, 1), b2 + hstepB, voffB);
            PG8_WAIT_V(6); PG8_BAR; PG8_MMA(1, 1, At, B1); PG8_BAR;
            PG8_LDB(B0, 1, 0); PG8_SCHED; PG8_LDA(At, 1, 0); PG8_STAGE(PG8_SA(0, 1), a2 + hstepA, voffA);
            PG8_WAIT_L(8); PG8_BAR; PG8_WAIT_L(0); PG8_MMA(0, 0, At, B0); PG8_BAR; PG8_SCHED;
            PG8_LDB(B1, 1, 1); PG8_STAGE(PG8_SB(1, 0), b3, voffB);
            PG8_BAR; PG8_WAIT_L(0); PG8_MMA(0, 1, At, B1); PG8_BAR;
            PG8_LDA(At, 1, 1); PG8_STAGE(PG8_SA(1, 0), a3, voffA);
            PG8_BAR; PG8_WAIT_L(0); PG8_MMA(1, 0, At, B0); PG8_BAR; PG8_SCHED;
            PG8_STAGE(PG8_SB(1, 1), b3 + hstepB, voffB);
            PG8_WAIT_V(6); PG8_BAR; PG8_MMA(1, 1, At, B1); PG8_BAR;
            }
        }
        if constexpr (ALIGN_EPI) { if (wr == 0) PG8_BAR; }
        E(acc, cur, wr, wc, fr, fq); S.done(cur);
        if (!has_next) break;
#pragma unroll
        for (int a = 0; a < 2; ++a)
#pragma unroll
            for (int b = 0; b < 2; ++b)
#pragma unroll
                for (int m = 0; m < 4; ++m)
#pragma unroll
                    for (int n = 0; n < 2; ++n) acc[a][b][m][n] = (f32x4){0.f, 0.f, 0.f, 0.f};
        cur = nxt; cA = nA; cB = nB; ++ui;
        if constexpr (ALIGN_EPI) { if (wr == 1) PG8_BAR; }
    }
    PG8_WAIT_V(0);
    if constexpr (!ALIGN_EPI) { if (wr == 0) PG8_BAR; }
    PG8_BAR;
#undef PG8_SA
#undef PG8_SB
#undef PG8_STAGE
#undef PG8_LDA
#undef PG8_LDB
#undef PG8_MMA
#undef PG8_WAIT_V
#undef PG8_WAIT_L
#undef PG8_BAR
#undef PG8_SCHED
#undef PG8_ABASE
}
__device__ __forceinline__ u32x4 pack8(const f32x4 v0, const f32x4 v1) { u32x4 w; w.x = cvt_pk_bf16(v0[0], v0[1]); w.y = cvt_pk_bf16(v0[2], v0[3]); w.z = cvt_pk_bf16(v1[0], v1[1]); w.w = cvt_pk_bf16(v1[2], v1[3]); return w; }
__device__ __forceinline__ f32x4 sig4(const f32x4 v) { f32x4 r; r.x = __builtin_amdgcn_rcpf(1.0f + __builtin_amdgcn_exp2f(-1.4426950408889634f * v.x)); r.y = __builtin_amdgcn_rcpf(1.0f + __builtin_amdgcn_exp2f(-1.4426950408889634f * v.y));
    r.z = __builtin_amdgcn_rcpf(1.0f + __builtin_amdgcn_exp2f(-1.4426950408889634f * v.z)); r.w = __builtin_amdgcn_rcpf(1.0f + __builtin_amdgcn_exp2f(-1.4426950408889634f * v.w)); return r; }
__device__ __forceinline__ void bf8_to_f32(const u32x4 w, f32x4& lo, f32x4& hi) { lo.x = __uint_as_float(w.x << 16); lo.y = __uint_as_float(w.x & 0xffff0000u); lo.z = __uint_as_float(w.y << 16); lo.w = __uint_as_float(w.y & 0xffff0000u);
    hi.x = __uint_as_float(w.z << 16); hi.y = __uint_as_float(w.z & 0xffff0000u); hi.z = __uint_as_float(w.w << 16); hi.w = __uint_as_float(w.w & 0xffff0000u); }
struct EpiZ { static constexpr bool PERM = true;
    unsigned char* ws; bf16* VT;
    __device__ __forceinline__ void operator()(const f32x4 (&acc)[2][2][4][2], const Unit& u, int wr, int wc, int fr, int fq) const {
        const int row0 = u.pm * BM + wr * 64 + fr, cw = wc * 32 + 8 * fq; bf16* QH = (bf16*)(ws + WS_QH);
        if (u.pn < 24) {
            const int part = u.pn >> 3, h0 = (u.pn & 7) * 2;
#pragma unroll
            for (int ai = 0; ai < 2; ++ai)
#pragma unroll
                for (int m = 0; m < 4; ++m) { const int row = row0 + ai * HALF + m * 16;
#pragma unroll
                    for (int bj = 0; bj < 2; ++bj) { const u32x4 w = pack8(acc[ai][bj][m][0], acc[ai][bj][m][1]);
                        *(u32x4*)(QH + (size_t)part * (16u << 20) + ((size_t)(h0 + bj) * S + row) * HD + cw) = w;
                        if (VT != nullptr && part == 2) { const unsigned ww[4] = {w.x, w.y, w.z, w.w};
#pragma unroll
                            for (int e = 0; e < 8; ++e) VT[((size_t)(h0 + bj) * HD + cw + e) * S + row] = (bf16)((ww[e >> 1] >> (16 * (e & 1))) & 0xffffu); } } }
        } else {
            const bool sg = u.pn >= 32; const int ld = u.pn < 32 ? PW : D, ct = u.pn < 32 ? u.pn - 24 : (u.pn < 48 ? u.pn - 32 : u.pn - 48);
            bf16* dst = (bf16*)(ws + (u.pn < 32 ? WS_PP : (u.pn < 48 ? WS_GA : WS_GP)));
#pragma unroll
            for (int ai = 0; ai < 2; ++ai)
#pragma unroll
                for (int m = 0; m < 4; ++m) { bf16* rowp = dst + (size_t)(row0 + ai * HALF + m * 16) * ld + ct * BM + cw;
#pragma unroll
                    for (int bj = 0; bj < 2; ++bj) { f32x4 v0 = acc[ai][bj][m][0], v1 = acc[ai][bj][m][1]; if (sg) { v0 = sig4(v0); v1 = sig4(v1); }
                        *(u32x4*)(rowp + bj * HALF) = pack8(v0, v1); } }
        }
    }
};
struct EpiT { static constexpr bool PERM = false;
    const bf16* GP; float* T;
    __device__ __forceinline__ void operator()(const f32x4 (&acc)[2][2][4][2], const Unit& u, int wr, int wc, int fr, int fq) const {
        const int row0 = u.pm * BM + wr * 64 + fr, col0 = u.pn * BM + wc * 32 + 4 * fq;
#pragma unroll
        for (int ai = 0; ai < 2; ++ai)
#pragma unroll
            for (int m = 0; m < 4; ++m) { const size_t off = (size_t)(row0 + ai * HALF + m * 16) * D + col0;
#pragma unroll
                for (int bj = 0; bj < 2; ++bj)
#pragma unroll
                    for (int n = 0; n < 2; ++n) { const u32x2 gw = *(const u32x2*)(GP + off + bj * HALF + n * 16); f32x4 gv; gv.x = __uint_as_float(gw.x << 16); gv.y = __uint_as_float(gw.x & 0xffff0000u); gv.z = __uint_as_float(gw.y << 16); gv.w = __uint_as_float(gw.y & 0xffff0000u);
                        *(f32x4*)(T + off + bj * HALF + n * 16) = acc[ai][bj][m][n] * gv; } }
    }
};
struct EpiM { static constexpr bool PERM = true;
    const bf16* GA; const float* T; bf16* MX;
    __device__ __forceinline__ void operator()(const f32x4 (&acc)[2][2][4][2], const Unit& u, int wr, int wc, int fr, int fq) const {
        const int row0 = u.pm * BM + wr * 64 + fr, col0 = u.pn * BM + wc * 32 + 8 * fq;
#pragma unroll
        for (int ai = 0; ai < 2; ++ai)
#pragma unroll
            for (int m = 0; m < 4; ++m) { const size_t off = (size_t)(row0 + ai * HALF + m * 16) * D + col0;
#pragma unroll
                for (int bj = 0; bj < 2; ++bj) { f32x4 g0, g1; bf8_to_f32(*(const u32x4*)(GA + off + bj * HALF), g0, g1);
                    const f32x4 t0 = *(const f32x4*)(T + off + bj * HALF), t1 = *(const f32x4*)(T + off + bj * HALF + 4);
                    *(u32x4*)(MX + off + bj * HALF) = pack8(acc[ai][bj][m][0] * g0 + t0, acc[ai][bj][m][1] * g1 + t1); } }
    }
};
struct EpiY { static constexpr bool PERM = false;
    const float* base; const float* gate; float* Y;
    __device__ __forceinline__ void operator()(const f32x4 (&acc)[2][2][4][2], const Unit& u, int wr, int wc, int fr, int fq) const {
        const int row0 = u.pm * BM + wr * 64 + fr, col0 = u.pn * BM + wc * 32 + 4 * fq;
        f32x4 gv[2][2];
#pragma unroll
        for (int bj = 0; bj < 2; ++bj)
#pragma unroll
            for (int n = 0; n < 2; ++n) gv[bj][n] = *(const f32x4*)(gate + col0 + bj * HALF + n * 16);
#pragma unroll
        for (int ai = 0; ai < 2; ++ai)
#pragma unroll
            for (int m = 0; m < 4; ++m) { const size_t off = (size_t)(row0 + ai * HALF + m * 16) * D + col0;
#pragma unroll
                for (int bj = 0; bj < 2; ++bj)
#pragma unroll
                    for (int n = 0; n < 2; ++n) { const f32x4 bs = *(const f32x4*)(base + off + bj * HALF + n * 16);
                        *(f32x4*)(Y + off + bj * HALF + n * 16) = bs * ALPHA + acc[ai][bj][m][n] * gv[bj][n]; } }
    }
};
struct EpiGU { static constexpr bool PERM = true;
    bf16* ACT;
    __device__ __forceinline__ void operator()(const f32x4 (&acc)[2][2][4][2], const Unit& u, int wr, int wc, int fr, int fq) const {
        const int row0 = u.pm * BM + wr * 64 + fr, j0 = u.pn * HALF + wc * 32 + 8 * fq;
#pragma unroll
        for (int ai = 0; ai < 2; ++ai)
#pragma unroll
            for (int m = 0; m < 4; ++m) { const f32x4 a0 = acc[ai][0][m][0] * sig4(acc[ai][0][m][0]) * acc[ai][1][m][0], a1 = acc[ai][0][m][1] * sig4(acc[ai][0][m][1]) * acc[ai][1][m][1];
                *(u32x4*)(ACT + (size_t)(row0 + ai * HALF + m * 16) * FFN + j0) = pack8(a0, a1); }
    }
};
}

namespace att {
constexpr int NW = 8, QBLK = 32, KVBLK = 64, QB = NW * QBLK;
constexpr int SHM_V = KVBLK * HD * 2, SHM_K = KVBLK * HD * 2;
constexpr int OFF_WS = 3 * SHM_V + 2 * SHM_K, OFF_B = OFF_WS + NW * 64 * 4, LDS_ATT = OFF_B + 2 * 256;
static_assert(LDS_ATT <= 131072, "attention LDS");
constexpr float THR = 8.f;
#define KSWZ(row, colB) ((row) * 256 + ((colB) ^ (((row) & 7) << 4)))
#define SBAR() __builtin_amdgcn_sched_barrier(0)
__device__ __forceinline__ int v_st(int k, int c) { const int kk = (k & ~0xC) | ((k & 4) << 1) | ((k & 8) >> 1); return ((kk >> 3) * 4 + (c >> 5)) * 512 + ((kk & 7) * 32 + (c & 31)) * 2; }
__device__ __forceinline__ int v_rd_base(int lane) { return ((lane & 3) << 3) | (((lane >> 2) & 3) << 6) | (((lane >> 4) & 1) << 5) | (((lane >> 5) & 1) << 8); }
constexpr int v_rd_off(int d0, int ks, int half) { return d0 * 512 + ks * 4096 + half * 2048; }
__device__ __forceinline__ bf16x8 pack8v(f32x4 a, f32x4 b) { u32x4 w = {cvt_pk_bf16(a[0], a[1]), cvt_pk_bf16(a[2], a[3]), cvt_pk_bf16(b[0], b[1]), cvt_pk_bf16(b[2], b[3])}; return *reinterpret_cast<bf16x8*>(&w); }
__device__ __forceinline__ void mask_tile(f32x16& p0, f32x16& p1, int dq) {
    const float NEG = -__builtin_inff();
#pragma unroll
    for (int r = 0; r < 16; ++r) { const int c = (r & 3) + 8 * (r >> 2); if (dq - c < 0) p0[r] = NEG; if (dq - c - 32 < 0) p1[r] = NEG; }
}
__device__ __forceinline__ void add_bias(f32x16& p0, f32x16& p1, LAS const char* bl_) {
    LAS const float* bl = (LAS const float*)bl_;
#pragma unroll
    for (int i = 0; i < 4; ++i) { const f32x4 a = *(LAS const f32x4*)(bl + 8 * i), b = *(LAS const f32x4*)(bl + 32 + 8 * i);
        p0[4 * i] += a[0]; p0[4 * i + 1] += a[1]; p0[4 * i + 2] += a[2]; p0[4 * i + 3] += a[3]; p1[4 * i] += b[0]; p1[4 * i + 1] += b[1]; p1[4 * i + 2] += b[2]; p1[4 * i + 3] += b[3]; }
}
__device__ __forceinline__ void partialSM(f32x16& p0, f32x16& p1, float& m_reg, float& mn, float& alpha) {
    float pmax = p0[0];
#pragma unroll
    for (int r = 1; r < 16; ++r) pmax = fmaxf(pmax, p0[r]);
#pragma unroll
    for (int r = 0; r < 16; ++r) pmax = fmaxf(pmax, p1[r]);
    { auto rr = __builtin_amdgcn_permlane32_swap(__float_as_uint(pmax), __float_as_uint(pmax), false, false); pmax = fmaxf(__uint_as_float(rr[0]), __uint_as_float(rr[1])); }
    constexpr float C2 = 1.4426950408889634f * ATT_SCALE;
    if (__builtin_expect(__all((pmax - m_reg) * ATT_SCALE <= THR), 1)) { mn = m_reg; alpha = 1.f; }
    else { mn = fmaxf(m_reg, pmax); alpha = __builtin_amdgcn_exp2f((m_reg - mn) * C2); m_reg = mn; }
    const float mnL = -mn * C2;
#pragma unroll
    for (int r = 0; r < 16; ++r) p0[r] = fmaf(p0[r], C2, mnL);
#pragma unroll
    for (int r = 0; r < 16; ++r) p1[r] = fmaf(p1[r], C2, mnL);
#pragma unroll
    for (int r = 0; r < 16; ++r) p0[r] = __builtin_amdgcn_exp2f(p0[r]);
}
__device__ __forceinline__ void finishSM(f32x16& p0, f32x16& p1, float alpha, float& l_reg, bf16x8& pa0, bf16x8& pa1, bf16x8& pa2, bf16x8& pa3) {
#pragma unroll
    for (int r = 0; r < 16; ++r) p1[r] = __builtin_amdgcn_exp2f(p1[r]);
    float ps = 0;
#pragma unroll
    for (int r = 0; r < 16; ++r) ps += p0[r];
#pragma unroll
    for (int r = 0; r < 16; ++r) ps += p1[r];
    { auto rr = __builtin_amdgcn_permlane32_swap(__float_as_uint(ps), __float_as_uint(ps), false, false); ps = __uint_as_float(rr[0]) + __uint_as_float(rr[1]); }
    l_reg = l_reg * alpha + ps;
#define PK4(P, B_, OUT) do { unsigned a0 = cvt_pk_bf16(P[B_+0], P[B_+1]), a1 = cvt_pk_bf16(P[B_+2], P[B_+3]);                          \
        unsigned b0 = cvt_pk_bf16(P[B_+4], P[B_+5]), b1 = cvt_pk_bf16(P[B_+6], P[B_+7]);                                             \
        auto r0 = __builtin_amdgcn_permlane32_swap(a0, b0, false, false); auto r1 = __builtin_amdgcn_permlane32_swap(a1, b1, false, false); \
        u32x4 w = {r0[0], r1[0], r0[1], r1[1]}; OUT = *reinterpret_cast<bf16x8*>(&w); } while (0)
    PK4(p0, 0, pa0); PK4(p0, 8, pa1); PK4(p1, 0, pa2); PK4(p1, 8, pa3);
#undef PK4
}
template <int KB>
__device__ __forceinline__ void qkt(f32x16& p0, f32x16& p1, LAS const char* K_lds, int r32, int hi, const bf16x8* qr) {
#pragma unroll
    for (int r = 0; r < 16; ++r) { p0[r] = 0.f; p1[r] = 0.f; }
    LAS const char* kb[4];
#pragma unroll
    for (int dd = 0; dd < 4; ++dd) kb[dd] = K_lds + KB * SHM_K + KSWZ(r32, (dd * 16 + hi * 8) * 2);
#pragma unroll
    for (int d0 = 0; d0 < 8; ++d0) { LAS const char* a = kb[d0 & 3] + (d0 >> 2) * 128;
        bf16x8 b0 = *reinterpret_cast<LAS const bf16x8*>(a);
        bf16x8 b1 = *reinterpret_cast<LAS const bf16x8*>(a + 32 * 256);
        p0 = __builtin_amdgcn_mfma_f32_32x32x16_bf16(b0, qr[d0], p0, 0, 0, 0);
        p1 = __builtin_amdgcn_mfma_f32_32x32x16_bf16(b1, qr[d0], p1, 0, 0, 0); }
}
template <int VB>
__device__ __forceinline__ void pv_tile(f32x16* o, int vb0, bf16x8 pa0, bf16x8 pa1, bf16x8 pa2, bf16x8 pa3) {
#define TRRD(dst, off) asm volatile("ds_read_b64_tr_b16 %0, %1 offset:%2" : "=&v"(dst) : "v"(vb0), "i"(off) : "memory")
#define PV_D0(d0) do { s16x4 l0, l1, l2, l3, h0, h1, h2, h3; constexpr int b_ = VB * SHM_V + v_rd_off(d0, 0, 0);    \
        TRRD(l0, b_); TRRD(h0, b_ + 2048); TRRD(l1, b_ + 4096); TRRD(h1, b_ + 6144); TRRD(l2, b_ + 8192); TRRD(h2, b_ + 10240); TRRD(l3, b_ + 12288); TRRD(h3, b_ + 14336); \
        asm volatile("s_waitcnt lgkmcnt(0)" ::: "memory"); SBAR();   \
        o[d0] = __builtin_amdgcn_mfma_f32_32x32x16_bf16(pa0, (bf16x8){l0[0], l0[1], l0[2], l0[3], h0[0], h0[1], h0[2], h0[3]}, o[d0], 0, 0, 0);   \
        o[d0] = __builtin_amdgcn_mfma_f32_32x32x16_bf16(pa1, (bf16x8){l1[0], l1[1], l1[2], l1[3], h1[0], h1[1], h1[2], h1[3]}, o[d0], 0, 0, 0);   \
        o[d0] = __builtin_amdgcn_mfma_f32_32x32x16_bf16(pa2, (bf16x8){l2[0], l2[1], l2[2], l2[3], h2[0], h2[1], h2[2], h2[3]}, o[d0], 0, 0, 0);   \
        o[d0] = __builtin_amdgcn_mfma_f32_32x32x16_bf16(pa3, (bf16x8){l3[0], l3[1], l3[2], l3[3], h3[0], h3[1], h3[2], h3[3]}, o[d0], 0, 0, 0); } while (0)
    PV_D0(0); PV_D0(1); PV_D0(2); PV_D0(3);
#undef PV_D0
#undef TRRD
}
struct BlockRef { const bf16* Q; const bf16* K; const bf16* V; const float* B; bf16* O; int P0; };
#define VMW() asm volatile("s_waitcnt vmcnt(0)" ::: "memory")
__device__ __forceinline__ void block(const BlockRef& cur, LAS char* lds) {
    const int tid = threadIdx.x, wid = __builtin_amdgcn_readfirstlane(tid >> 6), lane = tid & 63, r32 = lane & 31, hi = lane >> 5;
    const int NT = (cur.P0 + QB - 1) / KVBLK + 1;
    const int qlo = cur.P0 + wid * QBLK, qm = qlo + r32 - 4 * hi;
    LAS char* V_lds = lds; LAS char* K_lds = lds + 3 * SHM_V; LAS char* B_lds = lds + OFF_B;
    LAS float* wsl = (LAS float*)(lds + OFF_WS) + wid * 64; LAS float* li_l = wsl; LAS float* al_l = wsl + 32;
    int kofs, vofs;
    { const int q = wid * 64 + lane;
        { const int row = q >> 4, cp = q & 15, c = cp ^ (row & 7); kofs = row * HD + c * 8; }
        { const int st = q >> 5, kkl = (q >> 2) & 7, cq = q & 3, kk = (st >> 2) * 8 + kkl, c = (st & 3) * 32 + cq * 8, k = (kk & ~0xC) | ((kk & 4) << 1) | ((kk & 8) >> 1); vofs = k * HD + c; } }
    const bf16* Kh = cur.K; const bf16* Vh = cur.V; const float* Bh = cur.B;
#define DMA_TILE(t_, kb_, vs_) do { const int k0_ = (t_) * KVBLK;                                                                                               \
        if (wid == 0) __builtin_amdgcn_global_load_lds((const unsigned*)(Bh + k0_ + lane), (LAS unsigned*)(B_lds + (kb_) * 256), 4, 0, 0);                 \
        _Pragma("unroll") for (int j_ = 0; j_ < 2; ++j_) __builtin_amdgcn_global_load_lds((const unsigned*)(Kh + (size_t)(k0_ + 32 * j_) * HD + kofs), (LAS unsigned*)(K_lds + (kb_) * SHM_K + (j_ * 8 + wid) * 1024), 16, 0, 0); \
        _Pragma("unroll") for (int j_ = 0; j_ < 2; ++j_) __builtin_amdgcn_global_load_lds((const unsigned*)(Vh + (size_t)(k0_ + 32 * j_) * HD + vofs), (LAS unsigned*)(V_lds + (vs_) * SHM_V + (j_ * 8 + wid) * 1024), 16, 0, 0); } while (0)
    DMA_TILE(0, 0, 0);
    bf16x8 qr[8];
#pragma unroll
    for (int d0 = 0; d0 < 8; ++d0) qr[d0] = *(const bf16x8*)(cur.Q + (size_t)(wid * QBLK + r32) * HD + d0 * 16 + hi * 8);
    float m_reg = -1e30f, l_reg = 0; f32x16 o[4];
#pragma unroll
    for (int d = 0; d < 4; ++d)
#pragma unroll
        for (int r = 0; r < 16; ++r) o[d][r] = 0.f;
    const int vb0 = (int)(unsigned)(uintptr_t)V_lds + v_rd_base(lane);
#define RESC(a) do { if (__any((a) < 1.f)) { if (hi == 0) al_l[r32] = (a); asm volatile("s_waitcnt lgkmcnt(0)" ::: "memory");              \
                     _Pragma("unroll") for (int d_ = 0; d_ < 4; ++d_) _Pragma("unroll") for (int r = 0; r < 16; ++r) o[d_][r] *= al_l[crow(r, hi)]; } } while (0)
#define KBASE(t) ((t) * KVBLK)
#define MASKT(P0_, P1_, t, kb_) do { const int kbs_ = KBASE(t); add_bias(P0_, P1_, B_lds + (kb_) * 256 + 16 * hi); if (kbs_ + KVBLK - 1 > qlo) mask_tile(P0_, P1_, qm - kbs_); } while (0)
    f32x16 pA0, pA1, pB0, pB1; float mnA, mnB, alA, alB; bf16x8 pa0, pa1, pa2, pa3;
    VMW(); __syncthreads();
    if (NT > 1) DMA_TILE(1, 1, 1);
    SBAR(); qkt<0>(pA0, pA1, K_lds, r32, hi, qr);
    MASKT(pA0, pA1, 0, 0); partialSM(pA0, pA1, m_reg, mnA, alA);
    VMW(); __syncthreads();
    int vs = 0;
#define HALF_STEP(PX0, PX1, mnX, alX, PY0, PY1, alY, t, KB) do {                                                      \
        SBAR(); qkt<KB>(PX0, PX1, K_lds, r32, hi, qr);                                             \
        finishSM(PY0, PY1, alY, l_reg, pa0, pa1, pa2, pa3); SBAR();                                                           \
        if ((t) + 1 < NT) { DMA_TILE((t) + 1, (KB) ^ 1, (vs == 0 ? 2 : vs - 1)); SBAR(); }                                               \
        pv_tile<0>(o, vb0 + vs * SHM_V, pa0, pa1, pa2, pa3); MASKT(PX0, PX1, (t), KB); partialSM(PX0, PX1, m_reg, mnX, alX);                                        \
        RESC(alX); VMW(); __syncthreads(); vs = (vs == 2 ? 0 : vs + 1); } while (0)
    for (int t = 1; t + 1 < NT; t += 2) {
        HALF_STEP(pB0, pB1, mnB, alB, pA0, pA1, alA, t, 1);
        HALF_STEP(pA0, pA1, mnA, alA, pB0, pB1, alB, t + 1, 0);
    }
    const bool even = (NT & 1) == 0;
    if (even) { SBAR(); qkt<1>(pB0, pB1, K_lds, r32, hi, qr); SBAR(); }
    finishSM(pA0, pA1, alA, l_reg, pa0, pa1, pa2, pa3); SBAR();
    pv_tile<0>(o, vb0 + vs * SHM_V, pa0, pa1, pa2, pa3);
    if (even) { vs = (vs == 2 ? 0 : vs + 1); MASKT(pB0, pB1, NT - 1, 1); partialSM(pB0, pB1, m_reg, mnB, alB); RESC(alB);
        finishSM(pB0, pB1, alB, l_reg, pa0, pa1, pa2, pa3); SBAR(); pv_tile<0>(o, vb0 + vs * SHM_V, pa0, pa1, pa2, pa3); }
    SBAR();
    if (hi == 0) li_l[r32] = l_reg; asm volatile("s_waitcnt lgkmcnt(0)" ::: "memory");
    float rli[16];
#pragma unroll
    for (int r = 0; r < 16; ++r) rli[r] = __builtin_amdgcn_rcpf(li_l[crow(r, hi)]);
    bf16* Ow = cur.O + (size_t)(wid * QBLK) * FW + r32; asm volatile("" : "+v"(Ow));
#pragma unroll
    for (int r = 0; r < 16; ++r) { const int orow = crow(r, hi);
#pragma unroll
        for (int d0 = 0; d0 < 4; ++d0) { const float v = o[d0][r] * rli[r]; const float vn = __shfl_xor(v, 1);
            if ((r32 & 1) == 0) *(GAS unsigned*)(Ow + (size_t)orow * FW + d0 * 32) = cvt_pk_bf16(v, vn); } }
    __syncthreads();
#undef RESC
#undef KBASE
#undef MASKT
#undef HALF_STEP
#undef DMA_TILE
}
#undef VMW
__device__ __forceinline__ BlockRef make_ref(unsigned char* ws, int L, int pass) {
    const int xcd = L & 7, k = L >> 3, h = 2 * xcd + (k >> 4), x = k & 15, qb = pass ? 31 - x : x;
    BlockRef r; r.Q = (const bf16*)(ws + WS_QH) + ((size_t)h * S + (size_t)qb * QB) * HD; r.K = (const bf16*)(ws + WS_KH) + (size_t)h * S * HD; r.V = (const bf16*)(ws + WS_VH) + (size_t)h * S * HD;
    r.B = (const float*)(ws + WS_BK) + (size_t)h * S; r.O = (bf16*)(ws + WS_AO) + (size_t)qb * QB * FW + h * HD; r.P0 = qb * QB; return r;
}
__device__ __forceinline__ void attn_phase(unsigned char* ws, LAS char* lds, int G) {
    for (int L = blockIdx.x; L < 256; L += G)
        for (int pass = 0; pass < 2; ++pass) { const BlockRef cur = make_ref(ws, L, pass); block(cur, lds); }
}
#undef KSWZ
#undef SBAR
}

typedef GAS unsigned gu32;
#define RLX_AGENT __ATOMIC_RELAXED, __HIP_MEMORY_SCOPE_AGENT
#define XB_TMO      128
#define XB_XCNT(j)  (256  + 64 * (j))
#define XB_XSUB(j)  (1280 + 64 * (j))
#define XB_XGEN(j)  (2304 + 64 * (j))
#define XB_TOP      3328
#define XB_TOPGEN   3392
#define XCD_BAR_WORDS 3456
#define XB_SPIN_CAP (1u << 18)

__device__ __forceinline__ unsigned xb_ld(unsigned* p)              { return __hip_atomic_load(p, __ATOMIC_RELAXED, __HIP_MEMORY_SCOPE_AGENT); }
__device__ __forceinline__ unsigned xb_add(unsigned* p, unsigned v) { return __hip_atomic_fetch_add(p, v, __ATOMIC_RELAXED, __HIP_MEMORY_SCOPE_AGENT); }
__device__ __forceinline__ unsigned xb_xcc_id() { return (unsigned)__builtin_amdgcn_s_getreg((3 << 11) | 20) & 0xFu; }
#define XB_SPIN(cond, bar) do { unsigned _sp = 0; while (cond) { __builtin_amdgcn_s_sleep(1); \
    if ((++_sp & 255u) == 0u) { if (xb_ld(&(bar)[XB_TMO])) break; if (_sp > XB_SPIN_CAP) { atomicAdd(&(bar)[XB_TMO], 1u); break; } } } } while (0)

struct XcdBarrier {
    unsigned* bar; unsigned x;
    volatile LAS unsigned* st;
};

__device__ __forceinline__ XcdBarrier xcd_barrier_post(unsigned* bar, volatile LAS unsigned* st) {
    XcdBarrier b; b.bar = bar; b.x = xb_xcc_id(); b.st = st;
    if (threadIdx.x == 0) (void)xb_add(&bar[XB_XCNT(b.x)], 1u);
    return b;
}
__device__ __forceinline__ void xcd_barrier_complete(unsigned* bar, unsigned x, unsigned& nloc, unsigned& nx) {
    const unsigned G = gridDim.x * gridDim.y * gridDim.z;
    unsigned sum, cnt, mine, sp = 0u;
    for (;;) {
        sum = 0u; cnt = 0u; mine = 0u;
#pragma unroll
        for (unsigned j = 0; j < 16; ++j) { const unsigned c = xb_ld(&bar[XB_XCNT(j)]); sum += c; cnt += (c > 0u) ? 1u : 0u; mine = (j == x) ? c : mine; }
        if (sum == G) break;
        __builtin_amdgcn_s_sleep(1);
        if ((++sp & 255u) == 0u) { if (xb_ld(&bar[XB_TMO])) break; if (sp > XB_SPIN_CAP) { atomicAdd(&bar[XB_TMO], 1u); break; } }
    }
    nloc = mine > 0u ? mine : 1u; nx = cnt > 0u ? cnt : 1u;
}

__device__ __forceinline__ void xcd_barrier(const XcdBarrier& b) {
    asm volatile("s_waitcnt vmcnt(0)" ::: "memory");
    __syncthreads();
    if (threadIdx.x == 0) {
        unsigned* bar = b.bar;
        __builtin_amdgcn_s_waitcnt(0);
        unsigned nloc = b.st[0], nx = b.st[1];
        if (nloc == 0u) { xcd_barrier_complete(bar, b.x, nloc, nx); b.st[0] = nloc; b.st[1] = nx; }
        const unsigned old = xb_add(&bar[XB_XSUB(b.x)], 1u);
        const unsigned gen = old / nloc;
        if (old + 1u == (gen + 1u) * nloc) {
            __builtin_amdgcn_fence(__ATOMIC_RELEASE, "agent");
            asm volatile("s_waitcnt vmcnt(0)" ::: "memory");
            const unsigned og = xb_add(&bar[XB_TOP], 1u);
            const unsigned tg = og / nx;
            if (og + 1u == (tg + 1u) * nx) xb_add(&bar[XB_TOPGEN], 1u);
            else XB_SPIN(xb_ld(&bar[XB_TOPGEN]) == tg, bar);
            __builtin_amdgcn_fence(__ATOMIC_ACQUIRE, "agent");
            xb_add(&bar[XB_XGEN(b.x)], 1u);
            asm volatile("s_waitcnt vmcnt(0)" ::: "memory");
        } else {
            XB_SPIN(xb_ld(&bar[XB_XGEN(b.x)]) == gen, bar);
            __builtin_amdgcn_fence(__ATOMIC_ACQUIRE, "agent");
            asm volatile("s_waitcnt vmcnt(0)" ::: "memory");
        }
    }
    __syncthreads();
}


struct Args { const float* in[16]; float* out; unsigned char* ws; int ph_lo, ph_hi; };
constexpr int N_PHASES = 12;
#ifndef FAST_MASK_V
#define FAST_MASK_V 63
#endif
constexpr int FAST_MASK = FAST_MASK_V;
#ifndef SIMPLE_ATTN_V
#define SIMPLE_ATTN_V false
#endif
constexpr bool SIMPLE_ATTN = SIMPLE_ATTN_V;

__global__ void __launch_bounds__(NTHREADS, 2) fwd_kernel(Args args) {
    extern __shared__ __attribute__((aligned(16))) unsigned char lds[];
    Ctx C;
    C.lds = (LAS unsigned char*)lds; C.tid = threadIdx.x; C.lane = C.tid & 63; C.wave = __builtin_amdgcn_readfirstlane(C.tid >> 6); C.G = gridDim.x;
    C.x = args.in[0]; C.c = args.in[1]; C.w_ada = args.in[2]; C.b_ada = args.in[3]; C.w_in = args.in[4]; C.b_forget = args.in[5]; C.w_attn_out = args.in[6]; C.w_pool = args.in[7];
    C.pool_scale = args.in[8]; C.w_out = args.in[9]; C.ln1_g = args.in[10]; C.ln1_b = args.in[11]; C.w_gate_up = args.in[12]; C.w_down = args.in[13]; C.ln2_g = args.in[14]; C.ln2_b = args.in[15];
    C.out = args.out; C.ws = args.ws;
    const int lo = args.ph_lo, hi = args.ph_hi;
    volatile LAS unsigned* MISC = (volatile LAS unsigned*)(C.lds + MISC_OFF);
    for (int u = C.tid; u < 32; u += NTHREADS) MISC[u] = 0u;
    __syncthreads();
    XcdBarrier bar = xcd_barrier_post((unsigned*)(C.ws + WS_CTL) + CW_BAR, MISC + 8);
#define IN(k) (lo <= (k) && (k) < hi)
#define SEAM(k) do { if (IN(k) && IN((k) + 1)) xcd_barrier(bar); } while (0)
    if (IN(0)) ph_prologue(C);
    SEAM(0);
    if (IN(1)) ph_ln1(C);
    SEAM(1);
    if (IN(2)) { ph_flogit(C); __syncthreads();
        if constexpr (FAST_MASK & 1) { pg8::Gemm g{WSP(bf16, WS_U), WSP(bf16, WS_WZ), S, NZ, D, D, 1 << 20, 0}; pg8::StaticOrder So; So.init(S, NZ, C.G, (int)blockIdx.x);
            pg8::EpiZ E{C.ws, SIMPLE_ATTN ? WSP(bf16, WS_VT) : (bf16*)nullptr};
            pg8::gemm_phase<pg8::EpiZ, pg8::StaticOrder, true, true>(C.lds, g, So, E); }
        else { EZs E{WSP(bf16, WS_QH), WSP(bf16, WS_VT), WSP(bf16, WS_PP), WSP(bf16, WS_GA), WSP(bf16, WS_GP)};
            sgemm_phase<false>(C, WSP(bf16, WS_U), D, WSP(bf16, WS_WZ), D, S, NZ, D, 1 << 30, 0, E); } }
    SEAM(2);
    if (IN(3)) ph_scan_pool(C);
    SEAM(3);
    if (IN(4)) { if constexpr (SIMPLE_ATTN) ph_attn_simple(C); else att::attn_phase(C.ws, (LAS char*)C.lds, C.G); }
    SEAM(4);
    if (IN(5)) {
        if constexpr (FAST_MASK & 2) { pg8::Gemm g{WSP(bf16, WS_PL), WSP(bf16, WS_WP), S, D, 512, PW, 4, 512}; pg8::StaticOrder So; So.init(S, D, C.G, (int)blockIdx.x);
            pg8::EpiT E{WSP(bf16, WS_GP), WSP(float, WS_T)}; pg8::gemm_phase<pg8::EpiT, pg8::StaticOrder, true, true>(C.lds, g, So, E); }
        else { ETs E{WSP(bf16, WS_GP), WSP(float, WS_T)}; sgemm_phase<false>(C, WSP(bf16, WS_PL), PW, WSP(bf16, WS_WP), 512, S, D, 512, 1024, 512, E); } }
    SEAM(5);
    if (IN(6)) {
        if constexpr (FAST_MASK & 4) { pg8::Gemm g{WSP(bf16, WS_AO), WSP(bf16, WS_WA), S, D, FW, FW, 1 << 20, 0}; pg8::StaticOrder So; So.init(S, D, C.G, (int)blockIdx.x);
            pg8::EpiM E{WSP(bf16, WS_GA), WSP(float, WS_T), WSP(bf16, WS_MX)}; pg8::gemm_phase<pg8::EpiM, pg8::StaticOrder, true, true>(C.lds, g, So, E); }
        else { EMs E{WSP(bf16, WS_GA), WSP(float, WS_T), WSP(bf16, WS_MX)}; sgemm_phase<false>(C, WSP(bf16, WS_AO), FW, WSP(bf16, WS_WA), FW, S, D, FW, 1 << 30, 0, E); } }
    SEAM(6);
    if (IN(7)) {
        if constexpr (FAST_MASK & 8) { pg8::Gemm g{WSP(bf16, WS_MX), WSP(bf16, WS_WO), S, D, D, D, 1 << 20, 0}; pg8::StaticOrder So; So.init(S, D, C.G, (int)blockIdx.x);
            pg8::EpiY E{C.x, WSP(float, WS_MOD) + 2 * D, WSP(float, WS_Y)}; pg8::gemm_phase<pg8::EpiY, pg8::StaticOrder, true, true>(C.lds, g, So, E); }
        else { EYs E{C.x, WSP(float, WS_MOD) + 2 * D, WSP(float, WS_Y)}; sgemm_phase<false>(C, WSP(bf16, WS_MX), D, WSP(bf16, WS_WO), D, S, D, D, 1 << 30, 0, E); } }
    SEAM(7);
    if (IN(8)) ph_ln_mid(C);
    SEAM(8);
    if (IN(9)) {
        if constexpr (FAST_MASK & 16) { pg8::Gemm g{WSP(bf16, WS_U), WSP(bf16, WS_WGU), S, NGU, D, D, 1 << 20, 0}; pg8::StaticOrder So; So.init(S, NGU, C.G, (int)blockIdx.x);
            pg8::EpiGU E{WSP(bf16, WS_ACT)}; pg8::gemm_phase<pg8::EpiGU, pg8::StaticOrder, true, true>(C.lds, g, So, E); }
        else { EGUs E{WSP(bf16, WS_ACT)}; sgemm_phase<true>(C, WSP(bf16, WS_U), D, WSP(bf16, WS_WGU), D, S, NGU, D, 1 << 30, 0, E); } }
    SEAM(9);
    if (IN(10)) {
        if constexpr (FAST_MASK & 32) { pg8::Gemm g{WSP(bf16, WS_ACT), WSP(bf16, WS_WD), S, D, FFN, FFN, 1 << 20, 0}; pg8::StaticOrder So; So.init(S, D, C.G, (int)blockIdx.x);
            pg8::EpiY E{WSP(float, WS_X1), WSP(float, WS_MOD) + 5 * D, WSP(float, WS_Y)}; pg8::gemm_phase<pg8::EpiY, pg8::StaticOrder, true, true>(C.lds, g, So, E); }
        else { EYs E{WSP(float, WS_X1), WSP(float, WS_MOD) + 5 * D, WSP(float, WS_Y)}; sgemm_phase<false>(C, WSP(bf16, WS_ACT), FFN, WSP(bf16, WS_WD), FFN, S, D, FFN, 1 << 30, 0, E); } }
    SEAM(10);
    if (IN(11)) ph_ln_final(C);
#undef SEAM
#undef IN
}

extern "C" void kernel_launch(void* const* d_in, const int* in_sizes, int n_in, void* d_out, int out_size, void* d_ws, size_t ws_size, hipStream_t stream) {
    static int grid = 0;
    if (grid == 0) {
        if (n_in != 16 || in_sizes[0] != S * D || out_size != S * D || ws_size < WS_END) { fprintf(stderr, "kernel_launch: unexpected shapes (n_in %d, in0 %d, out %d, ws %zu < %zu)\n", n_in, n_in > 0 ? in_sizes[0] : -1, out_size, ws_size, (size_t)WS_END); grid = -1; return; }
        int dev = 0, cus = 0;
        if (hipGetDevice(&dev) != hipSuccess || hipDeviceGetAttribute(&cus, hipDeviceAttributeMultiprocessorCount, dev) != hipSuccess || cus <= 0) cus = 256;
        if (hipFuncSetAttribute((const void*)fwd_kernel, hipFuncAttributeMaxDynamicSharedMemorySize, LDS_BYTES) != hipSuccess) { fprintf(stderr, "kernel_launch: hipFuncSetAttribute failed\n"); grid = -1; return; }
        grid = cus;
    }
    if (grid < 0) return;
    Args a{};
    for (int i = 0; i < 16; ++i) a.in[i] = (const float*)d_in[i];
    a.out = (float*)d_out; a.ws = (unsigned char*)d_ws;
    if (hipMemsetAsync((char*)d_ws + WS_CTL, 0, CTL_ZERO_BYTES, stream) != hipSuccess) { fprintf(stderr, "kernel_launch: memset failed\n"); return; }
    a.ph_lo = 0; a.ph_hi = N_PHASES;
    hipLaunchKernelGGL(fwd_kernel, dim3(grid), dim3(NTHREADS), LDS_BYTES, stream, a);
}
```

```cpp
#include <hip/hip_runtime.h>
#include <cstdio>
#include <cstdint>

#define GAS __attribute__((address_space(1)))
#define LAS __attribute__((address_space(3)))
typedef unsigned short bf16;
typedef short bf16x8 __attribute__((ext_vector_type(8)));
typedef short s16x4 __attribute__((ext_vector_type(4)));
typedef float f32x4 __attribute__((ext_vector_type(4)));
typedef float f32x16 __attribute__((ext_vector_type(16)));
typedef unsigned u32x4 __attribute__((ext_vector_type(4)));
typedef unsigned u32x2 __attribute__((ext_vector_type(2)));

constexpr int S = 8192, D = 4096, NH = 16, HD = 128, FW = 2048, PW = 2048, FFN = 11008, INC = 16400, D6 = 6 * D;
constexpr int NZ = 16384;
constexpr int NGU = 2 * FFN;
constexpr float LN_EPS = 1e-5f;
constexpr float ALPHA = 1.189207115002721f;
constexpr float ATT_SCALE = 0.08838834764831845f;
constexpr float INV_ATT_SCALE = 11.313708498984761f;
constexpr int NWAVES = 8, NTHREADS = 512;
constexpr bool LATE_CONV_IN_QUEUE = true;
constexpr int ATT_TMAX = 48;
constexpr bool SKIP_TILES = true;

constexpr size_t MiB = 1u << 20;
constexpr size_t WS_CTL = 0;
constexpr size_t WS_MODP = 1 * MiB;
constexpr size_t WS_MOD = 2 * MiB;
constexpr size_t WS_FL = 3 * MiB;
constexpr size_t WS_BK = 4 * MiB;
constexpr size_t WS_WF = 5 * MiB;
constexpr size_t WS_WZ = 8 * MiB;
constexpr size_t WS_WA = WS_WZ + 128 * MiB;
constexpr size_t WS_WP = WS_WA + 16 * MiB;
constexpr size_t WS_WO = WS_WP + 4 * MiB;
constexpr size_t WS_WGU = WS_WO + 32 * MiB;
constexpr size_t WS_WD = WS_WGU + 172 * MiB;
constexpr size_t WS_U = WS_WD + 86 * MiB;
constexpr size_t WS_QH = WS_U + 64 * MiB;
constexpr size_t WS_KH = WS_QH + 32 * MiB;
constexpr size_t WS_VH = WS_KH + 32 * MiB;
constexpr size_t WS_VT = WS_VH + 32 * MiB;
constexpr size_t WS_PP = WS_VT + 32 * MiB;
constexpr size_t WS_GA = WS_PP + 32 * MiB;
constexpr size_t WS_GP = WS_GA + 64 * MiB;
constexpr size_t WS_ACT = WS_QH;
constexpr size_t WS_PL = WS_GP + 64 * MiB;
constexpr size_t WS_AO = WS_PL + 32 * MiB;
constexpr size_t WS_T = WS_AO + 32 * MiB;
constexpr size_t WS_MX = WS_T + 128 * MiB;
constexpr size_t WS_Y = WS_MX + 64 * MiB;
constexpr size_t WS_X1 = WS_Y + 128 * MiB;
constexpr size_t WS_END = WS_X1 + 128 * MiB;
static_assert(WS_QH + 172 * MiB <= WS_GP && WS_KH == WS_QH + 32 * MiB && WS_VH == WS_KH + 32 * MiB, "ACT overlay / QKV contiguity");

constexpr size_t WS_JLO = WS_MOD + 512 * 1024;
constexpr size_t WS_LIST = WS_JLO + 4096;
constexpr size_t WS_PART = WS_Y;
constexpr size_t PART_BYTES = 131072 + 2048;
static_assert(WS_X1 == WS_Y + 128 * MiB && (size_t)1152 * PART_BYTES <= 256 * MiB, "partials overlay");
constexpr int CW_NORM = 8192;
constexpr int CW_QCNT = 8448;
constexpr int LDS_BYTES = 147456;
constexpr int MISC_OFF = 131072 + 320;
constexpr int CW_BAR = 4096;
constexpr size_t CTL_ZERO_BYTES = 1u << 20;

__device__ __forceinline__ unsigned cvt_pk_bf16(float lo, float hi) { unsigned r; asm volatile("v_cvt_pk_bf16_f32 %0, %1, %2" : "=v"(r) : "v"(lo), "v"(hi)); return r; }
__device__ __forceinline__ bf16 f2bf(float f) { return (bf16)(cvt_pk_bf16(f, 0.f) & 0xffffu); }
__device__ __forceinline__ float bf2f(bf16 b) { return __uint_as_float(((unsigned)b) << 16); }
__device__ __forceinline__ float wave_sum(float v) {
#pragma unroll
    for (int o = 1; o < 64; o <<= 1) v += __shfl_xor(v, o);
    return v;
}
__device__ __forceinline__ float sigmoidf_(float x) { return 1.0f / (1.0f + __expf(-x)); }
__device__ __forceinline__ int opaque_tid() { int t = threadIdx.x; asm volatile("" : "+v"(t)); return t; }
#define LDS_WAIT() asm volatile("s_waitcnt lgkmcnt(0)" ::: "memory")
#define VM_WAIT() asm volatile("s_waitcnt vmcnt(0)" ::: "memory")

struct Ctx {
    LAS unsigned char* lds;
    int tid, lane, wave, G;
    const float *x, *c, *w_ada, *b_ada, *w_in, *b_forget, *w_attn_out, *w_pool, *pool_scale, *w_out, *ln1_g, *ln1_b, *w_gate_up, *w_down, *ln2_g, *ln2_b;
    float* out;
    unsigned char* ws;
};
#define WSP(T, off) ((T*)(C.ws + (off)))

constexpr int CONV_SCR = 64 * 144;
__device__ __forceinline__ void conv_item64(const float* W, int ldw, int k0, int srcn0, bf16* dst, int ldd, int dstr0, const float* rscale, LAS char* scr, int lane) {
    const int rr = lane >> 4, c4 = lane & 15;
    const float* src = W + (size_t)(k0 + 16 * rr) * ldw + srcn0 + 4 * c4;
    f32x4 v[16];
#pragma unroll
    for (int i = 0; i < 16; ++i) v[i] = *(const f32x4*)(src + (size_t)i * ldw);
    f32x4 sc = {1.f, 1.f, 1.f, 1.f}; if (rscale) sc = *(const f32x4*)(rscale + dstr0 + 4 * c4);
#pragma unroll
    for (int e = 0; e < 4; ++e)
#pragma unroll
        for (int h = 0; h < 2; ++h) { u32x4 w; w.x = cvt_pk_bf16(v[8 * h + 0][e] * sc[e], v[8 * h + 1][e] * sc[e]); w.y = cvt_pk_bf16(v[8 * h + 2][e] * sc[e], v[8 * h + 3][e] * sc[e]);
            w.z = cvt_pk_bf16(v[8 * h + 4][e] * sc[e], v[8 * h + 5][e] * sc[e]); w.w = cvt_pk_bf16(v[8 * h + 6][e] * sc[e], v[8 * h + 7][e] * sc[e]);
            *(LAS u32x4*)(scr + (16 * e + c4) * 144 + (16 * rr + 8 * h) * 2) = w; }
    LDS_WAIT(); asm volatile("" ::: "memory");
#pragma unroll
    for (int ip = 0; ip < 8; ++ip) { const int n = (lane >> 3) + 8 * ip; const u32x4 w = *(LAS u32x4*)(scr + (16 * (n & 3) + (n >> 2)) * 144 + (lane & 7) * 16);
        *(u32x4*)(dst + (size_t)(dstr0 + n) * ldd + k0 + 8 * (lane & 7)) = w; }
    LDS_WAIT(); asm volatile("" ::: "memory");
}
constexpr int CI_Z = 64 * 256, CI_P = 4 * 8 * 16, CI_A = 32 * 64, CI_O = 64 * 64, CI_GU = 64 * 344, CI_D = 172 * 64;
constexpr int CI_LATE = CI_P + CI_A + CI_O + CI_GU + CI_D;
__device__ __forceinline__ void conv_z_item(Ctx& C, int r, LAS char* scr, int lane) {
    const int kb = r >> 8, nb = r & 255;
    if (nb < 96) conv_item64(C.w_in, INC, 64 * kb, 64 * nb, WSP(bf16, WS_WZ), D, 64 * nb, nullptr, scr, lane);
    else conv_item64(C.w_in, INC, 64 * kb, 6160 + 64 * (nb - 96), WSP(bf16, WS_WZ), D, 6144 + 64 * (nb - 96), nullptr, scr, lane);
}
__device__ __forceinline__ void conv_late_item(Ctx& C, int r, LAS char* scr, int lane) {
    if (r < CI_P) { const int g = r >> 7, rem = r & 127, kb = rem >> 4, nb = rem & 15;
        conv_item64(C.w_pool + (size_t)g * 512 * 1024, 1024, 64 * kb, 64 * nb, WSP(bf16, WS_WP), 512, 1024 * g + 64 * nb, C.pool_scale, scr, lane); return; } r -= CI_P;
    if (r < CI_A) { const int kb = r >> 6, nb = r & 63; conv_item64(C.w_attn_out, D, 64 * kb, 64 * nb, WSP(bf16, WS_WA), FW, 64 * nb, nullptr, scr, lane); return; } r -= CI_A;
    if (r < CI_O) { const int kb = r >> 6, nb = r & 63; conv_item64(C.w_out, D, 64 * kb, 64 * nb, WSP(bf16, WS_WO), D, 64 * nb, nullptr, scr, lane); return; } r -= CI_O;
    if (r < CI_GU) { const int kb = r / 344, nb = r % 344, r0 = 64 * nb, tile = r0 >> 8, within = r0 & 255, half = within >> 7, j0 = tile * 128 + (within & 127);
        conv_item64(C.w_gate_up, NGU, 64 * kb, half * FFN + j0, WSP(bf16, WS_WGU), D, r0, nullptr, scr, lane); return; } r -= CI_GU;
    { const int kb = r >> 6, nb = r & 63; conv_item64(C.w_down, D, 64 * kb, 64 * nb, WSP(bf16, WS_WD), FFN, 64 * nb, nullptr, scr, lane); }
}

__device__ __forceinline__ void ph_prologue(Ctx& C) {
    {
        LAS float* sl = (LAS float*)C.lds;
        LAS float* red = sl + 512;
        float* modp = WSP(float, WS_MODP);
        for (int task = blockIdx.x; task < 256; task += C.G) {
            const int kg = task >> 5, cs = task & 31;
            { const float cv = C.c[512 * kg + C.tid]; sl[C.tid] = cv / (1.0f + __expf(-cv)); }
            __syncthreads();
            f32x4 acc[3] = {};
            const f32x4* wrow = (const f32x4*)(C.w_ada + (size_t)(512 * kg + 64 * C.wave) * D6) + cs * 192 + C.lane;
#pragma unroll 4
            for (int r = 0; r < 64; ++r) { const float s = sl[64 * C.wave + r];
#pragma unroll
                for (int q = 0; q < 3; ++q) { const f32x4 v = wrow[(size_t)r * (D6 / 4) + 64 * q]; acc[q] += v * s; } }
#pragma unroll
            for (int q = 0; q < 3; ++q) *(LAS f32x4*)(red + C.wave * 768 + (C.lane + 64 * q) * 4) = acc[q];
            __syncthreads();
            if (C.tid < 192) { f32x4 s = {0.f, 0.f, 0.f, 0.f};
#pragma unroll
                for (int w = 0; w < 8; ++w) s += *(LAS f32x4*)(red + w * 768 + C.tid * 4);
                *(f32x4*)(modp + (size_t)kg * D6 + cs * 768 + C.tid * 4) = s; }
            __syncthreads();
        }
    }
    {
        LAS char* scr = (LAS char*)(C.lds + C.wave * CONV_SCR);
        const int gw = blockIdx.x * NWAVES + C.wave, NGW = C.G * NWAVES;
        for (int it = gw; it < CI_Z; it += NGW) conv_z_item(C, it, scr, C.lane);
        if (!LATE_CONV_IN_QUEUE) for (int it = gw; it < CI_LATE; it += NGW) conv_late_item(C, it, scr, C.lane);
        bf16* wf = WSP(bf16, WS_WF);
        for (int g = blockIdx.x * NTHREADS + C.tid; g < 16 * D; g += C.G * NTHREADS) { const int h = g & 15, k = g >> 4; wf[h * D + k] = f2bf(C.w_in[(size_t)k * INC + 6144 + h]); }
    }
}

__device__ __forceinline__ void row_load(const float* rowp, int lane, f32x4 (&v)[16]) {
    const f32x4* p = (const f32x4*)rowp + lane;
#pragma unroll
    for (int j = 0; j < 16; ++j) v[j] = p[64 * j];
}
__device__ __forceinline__ void row_normalize(f32x4 (&v)[16]) {
    float s = 0.f;
#pragma unroll
    for (int j = 0; j < 16; ++j) s += (v[j].x + v[j].y) + (v[j].z + v[j].w);
    const float mean = wave_sum(s) * (1.0f / D); float s2 = 0.f;
#pragma unroll
    for (int j = 0; j < 16; ++j) { v[j] = v[j] - mean; s2 += (v[j].x * v[j].x + v[j].y * v[j].y) + (v[j].z * v[j].z + v[j].w * v[j].w); }
    const float rstd = 1.0f / sqrtf(wave_sum(s2) * (1.0f / D) + LN_EPS);
#pragma unroll
    for (int j = 0; j < 16; ++j) v[j] = v[j] * rstd;
}
__device__ __forceinline__ void mod_to_lds(Ctx& C, LAS float* dst, int chunk, float add) {
    const float* modp = WSP(float, WS_MODP);
    for (int c = C.tid; c < D; c += NTHREADS) { float s = C.b_ada[chunk * D + c];
#pragma unroll
        for (int kg = 0; kg < 8; ++kg) s += modp[(size_t)kg * D6 + chunk * D + c];
        dst[c] = s + add; }
}

__device__ __forceinline__ void ph_ln1(Ctx& C) {
    LAS float* sc = (LAS float*)C.lds; LAS float* sh = sc + D;
    mod_to_lds(C, sh, 0, 0.f); mod_to_lds(C, sc, 1, 1.f);
    { const float* modp = WSP(float, WS_MODP); float* mod = WSP(float, WS_MOD);
      for (int j = blockIdx.x * NTHREADS + C.tid; j < D6; j += C.G * NTHREADS) { float s = C.b_ada[j];
#pragma unroll
          for (int kg = 0; kg < 8; ++kg) s += modp[(size_t)kg * D6 + j];
          mod[j] = s; } }
    __syncthreads();
    bf16* U = WSP(bf16, WS_U);
    for (int row = blockIdx.x * NWAVES + C.wave; row < S; row += C.G * NWAVES) {
        f32x4 v[16]; row_load(C.x + (size_t)row * D, C.lane, v); row_normalize(v);
        u32x2* o = (u32x2*)(U + (size_t)row * D) + C.lane;
#pragma unroll
        for (int j = 0; j < 16; ++j) { const f32x4 a = *(LAS f32x4*)(sc + 4 * (C.lane + 64 * j)), b = *(LAS f32x4*)(sh + 4 * (C.lane + 64 * j)); const f32x4 r = v[j] * a + b;
            u32x2 w; w.x = cvt_pk_bf16(r.x, r.y); w.y = cvt_pk_bf16(r.z, r.w); o[64 * j] = w; }
    }
}
__device__ __forceinline__ void ph_ln_mid(Ctx& C) {
    LAS float* g = (LAS float*)C.lds; LAS float* b = g + D; LAS float* sc = b + D; LAS float* sh = sc + D;
    const float* mod = WSP(float, WS_MOD);
    for (int c = C.tid; c < D; c += NTHREADS) { g[c] = C.ln1_g[c]; b[c] = C.ln1_b[c]; sh[c] = mod[3 * D + c]; sc[c] = 1.0f + mod[4 * D + c]; }
    __syncthreads();
    bf16* U = WSP(bf16, WS_U); const float* Y = WSP(float, WS_Y); float* X1 = WSP(float, WS_X1);
    for (int row = blockIdx.x * NWAVES + C.wave; row < S; row += C.G * NWAVES) {
        f32x4 v[16]; row_load(Y + (size_t)row * D, C.lane, v); row_normalize(v);
        f32x4* xo = (f32x4*)(X1 + (size_t)row * D) + C.lane;
#pragma unroll
        for (int j = 0; j < 16; ++j) { const f32x4 a = *(LAS f32x4*)(g + 4 * (C.lane + 64 * j)), bb = *(LAS f32x4*)(b + 4 * (C.lane + 64 * j)); v[j] = v[j] * a + bb; xo[64 * j] = v[j]; }
        row_normalize(v);
        u32x2* o = (u32x2*)(U + (size_t)row * D) + C.lane;
#pragma unroll
        for (int j = 0; j < 16; ++j) { const f32x4 a = *(LAS f32x4*)(sc + 4 * (C.lane + 64 * j)), bb = *(LAS f32x4*)(sh + 4 * (C.lane + 64 * j)); const f32x4 r = v[j] * a + bb;
            u32x2 w; w.x = cvt_pk_bf16(r.x, r.y); w.y = cvt_pk_bf16(r.z, r.w); o[64 * j] = w; }
    }
}
__device__ __forceinline__ void ph_ln_final(Ctx& C) {
    LAS float* g = (LAS float*)C.lds; LAS float* b = g + D;
    for (int c = C.tid; c < D; c += NTHREADS) { g[c] = C.ln2_g[c]; b[c] = C.ln2_b[c]; }
    __syncthreads();
    const float* Y = WSP(float, WS_Y);
    for (int row = blockIdx.x * NWAVES + C.wave; row < S; row += C.G * NWAVES) {
        f32x4 v[16]; row_load(Y + (size_t)row * D, C.lane, v); row_normalize(v);
        f32x4* xo = (f32x4*)(C.out + (size_t)row * D) + C.lane;
#pragma unroll
        for (int j = 0; j < 16; ++j) { const f32x4 a = *(LAS f32x4*)(g + 4 * (C.lane + 64 * j)), bb = *(LAS f32x4*)(b + 4 * (C.lane + 64 * j)); xo[64 * j] = v[j] * a + bb; }
    }
}

__device__ __forceinline__ void ph_flogit(Ctx& C) {
    const bf16* U = WSP(bf16, WS_U); const bf16* WF = WSP(bf16, WS_WF); float* FL = WSP(float, WS_FL);
    LAS float* red = (LAS float*)C.lds;
    const int fr = C.lane & 15, fq = C.lane >> 4, rg = C.wave >> 2, kq = C.wave & 3;
    for (int blk = blockIdx.x; blk < S / 32; blk += C.G) {
        const int row = 32 * blk + 16 * rg + fr;
        const bf16* ap = U + (size_t)row * D + 1024 * kq + 8 * fq; const bf16* bp = WF + (size_t)fr * D + 1024 * kq + 8 * fq;
        f32x4 acc = {0.f, 0.f, 0.f, 0.f};
#pragma unroll 8
        for (int k = 0; k < 32; ++k) { const bf16x8 a = *(const bf16x8*)(ap + 32 * k), b = *(const bf16x8*)(bp + 32 * k); acc = __builtin_amdgcn_mfma_f32_16x16x32_bf16(a, b, acc, 0, 0, 0); }
        *(LAS f32x4*)(red + C.wave * 256 + C.lane * 4) = acc;
        __syncthreads();
        if (kq == 0) { f32x4 s = acc;
#pragma unroll
            for (int w = 1; w < 4; ++w) s += *(LAS f32x4*)(red + (C.wave + w) * 256 + C.lane * 4);
            s += C.b_forget[fr];
            *(f32x4*)(FL + (size_t)fr * S + 32 * blk + 16 * rg + 4 * fq) = s; }
        __syncthreads();
    }
}

__device__ __forceinline__ void ph_scan_pool(Ctx& C) {
    LAS float* wsum = (LAS float*)C.lds;
    LAS float* bke = wsum + 16; LAS float* bks = bke + 128; LAS int* jls = (LAS int*)(bks + 32);
    for (int h = blockIdx.x; h < NH; h += C.G) {
        const float* fl = WSP(float, WS_FL) + (size_t)h * S; float* bk = WSP(float, WS_BK) + (size_t)h * S;
        float v[16];
#pragma unroll
        for (int q = 0; q < 4; ++q) { const f32x4 t = *(const f32x4*)(fl + 16 * C.tid + 4 * q); v[4 * q] = t.x; v[4 * q + 1] = t.y; v[4 * q + 2] = t.z; v[4 * q + 3] = t.w; }
        float run = 0.f;
#pragma unroll
        for (int i = 0; i < 16; ++i) { const float xx = v[i]; const float ls = -(fmaxf(-xx, 0.f) + log1pf(__expf(-fabsf(xx)))); run += ls; v[i] = run; }
        float incl = run;
#pragma unroll
        for (int o = 1; o < 64; o <<= 1) { const float t = __shfl_up(incl, o); if (C.lane >= o) incl += t; }
        if (C.lane == 63) wsum[C.wave] = incl;
        __syncthreads();
        float off = incl - run;
        for (int w = 0; w < C.wave; ++w) off += wsum[w];
#pragma unroll
        for (int q = 0; q < 4; ++q) { f32x4 t; t.x = -(v[4 * q] + off) * INV_ATT_SCALE; t.y = -(v[4 * q + 1] + off) * INV_ATT_SCALE; t.z = -(v[4 * q + 2] + off) * INV_ATT_SCALE; t.w = -(v[4 * q + 3] + off) * INV_ATT_SCALE;
            *(f32x4*)(bk + 16 * C.tid + 4 * q) = t;
            if (q == 3 && (C.tid & 3) == 3) bke[C.tid >> 2] = t.w;
            if (q == 0 && (C.tid & 15) == 0) bks[C.tid >> 4] = t.x; }
        __syncthreads();
        if (C.tid < 32) { const int qb = C.tid; const unsigned* nrm = (const unsigned*)(C.ws + WS_CTL) + CW_NORM;
            float nq = 0.f, nk = 0.f;
#pragma unroll
            for (int w = 0; w < 4; ++w) { nq += __uint_as_float(__hip_atomic_load(nrm + (0 * 16 + h) * 4 + w, __ATOMIC_RELAXED, __HIP_MEMORY_SCOPE_AGENT)); nk += __uint_as_float(__hip_atomic_load(nrm + (1 * 16 + h) * 4 + w, __ATOMIC_RELAXED, __HIP_MEMORY_SCOPE_AGENT)); }
            const float Mh = 104.0f + 2.0f * 1.02f * ATT_SCALE * sqrtf(nq) * sqrtf(nk);
            int j = 0; while (j < 4 * qb && ATT_SCALE * (bke[j] - bks[qb]) < -Mh) ++j;
            const int jl = SKIP_TILES ? j : 0; ((int*)(C.ws + WS_JLO))[h * 32 + qb] = jl; jls[qb] = jl; }
        __syncthreads();
        if (C.tid == 0) { int* list = (int*)(C.ws + WS_LIST) + h * 96; int cnt = 0;
            for (int qb = 31; qb >= 0; --qb) { const int jlo = jls[qb], jhi = 4 * (qb + 1), n = jhi - jlo, P = (n + ATT_TMAX - 1) / ATT_TMAX, len = (n + P - 1) / P;
                for (int p = 0; p < P; ++p) { const int j0 = jlo + p * len, j1 = (j0 + len < jhi) ? j0 + len : jhi; list[1 + cnt++] = j0 | ((j1 - j0) << 8) | (qb << 16) | (p << 24) | ((P > 1 ? 1 : 0) << 28); } }
            list[0] = cnt; }
        __syncthreads();
    }
    const bf16* PP = WSP(bf16, WS_PP); bf16* PL = WSP(bf16, WS_PL);
    for (int gt = blockIdx.x * NTHREADS + C.tid; gt < (S / 16) * (PW / 8); gt += C.G * NTHREADS) {
        const int cc = gt & 255, rc = gt >> 8, g = cc >> 6, w = 2 << g, r0 = 16 * rc;
        const bf16* base = PP + 8 * cc; float sum[8] = {0.f, 0.f, 0.f, 0.f, 0.f, 0.f, 0.f, 0.f};
        for (int j = 1; j < w; ++j) { const int r = r0 - j; if (r >= 0) { const bf16x8 t = *(const bf16x8*)(base + (size_t)r * PW);
#pragma unroll
                for (int e = 0; e < 8; ++e) sum[e] += bf2f((bf16)t[e]); } }
        for (int i = 0; i < 16; ++i) { const int r = r0 + i; const bf16x8 t = *(const bf16x8*)(base + (size_t)r * PW);
            const float inv = 1.0f / (float)((r + 1) < w ? (r + 1) : w); float o[8];
#pragma unroll
            for (int e = 0; e < 8; ++e) { const float pv = bf2f((bf16)t[e]); sum[e] += pv; o[e] = sum[e] * inv - pv; }
            u32x4 ow; ow.x = cvt_pk_bf16(o[0], o[1]); ow.y = cvt_pk_bf16(o[2], o[3]); ow.z = cvt_pk_bf16(o[4], o[5]); ow.w = cvt_pk_bf16(o[6], o[7]);
            *(u32x4*)(PL + (size_t)r * PW + 8 * cc) = ow;
            const int ro = r - w + 1; if (ro >= 0) { const bf16x8 t2 = *(const bf16x8*)(base + (size_t)ro * PW);
#pragma unroll
                for (int e = 0; e < 8; ++e) sum[e] -= bf2f((bf16)t2[e]); } }
    }
}

template <bool PAIR, class Epi>
__device__ __forceinline__ void sgemm_phase(Ctx& C, const bf16* A, int lda, const bf16* Bt, int ldb, int M, int N, int K, int grp_cols, int grp_off, const Epi& E) {
    const int fr = C.lane & 15, fq = C.lane >> 4, wm = C.wave >> 2, wn = C.wave & 3;
    const int nTn = N / 256, nT = (M / 128) * nTn;
    for (int t = blockIdx.x; t < nT; t += C.G) {
        const int tm = t / nTn, tn = t % nTn, row0 = tm * 128 + wm * 64;
        const bf16* Ab = A + (size_t)((tn * 256) / grp_cols) * grp_off;
        int brow[4];
#pragma unroll
        for (int j = 0; j < 4; ++j) brow[j] = PAIR ? (tn * 256 + (j >> 1) * 128 + wn * 32 + (j & 1) * 16 + fr) : (tn * 256 + wn * 64 + 16 * j + fr);
        f32x4 acc[4][4];
#pragma unroll
        for (int i = 0; i < 4; ++i)
#pragma unroll
            for (int j = 0; j < 4; ++j) acc[i][j] = (f32x4){0.f, 0.f, 0.f, 0.f};
        for (int k0 = 0; k0 < K; k0 += 32) {
            bf16x8 a[4], b[4];
#pragma unroll
            for (int i = 0; i < 4; ++i) a[i] = *(const bf16x8*)(Ab + (size_t)(row0 + 16 * i + fr) * lda + k0 + 8 * fq);
#pragma unroll
            for (int j = 0; j < 4; ++j) b[j] = *(const bf16x8*)(Bt + (size_t)brow[j] * ldb + k0 + 8 * fq);
#pragma unroll
            for (int i = 0; i < 4; ++i)
#pragma unroll
                for (int j = 0; j < 4; ++j) acc[i][j] = __builtin_amdgcn_mfma_f32_16x16x32_bf16(a[i], b[j], acc[i][j], 0, 0, 0);
        }
        if constexpr (PAIR) {
#pragma unroll
            for (int i = 0; i < 4; ++i)
#pragma unroll
                for (int j = 0; j < 2; ++j)
#pragma unroll
                    for (int e = 0; e < 4; ++e) E(row0 + 16 * i + 4 * fq + e, tn * 128 + wn * 32 + j * 16 + fr, acc[i][j][e], acc[i][j + 2][e]);
        } else {
#pragma unroll
            for (int i = 0; i < 4; ++i)
#pragma unroll
                for (int j = 0; j < 4; ++j)
#pragma unroll
                    for (int e = 0; e < 4; ++e) E(row0 + 16 * i + 4 * fq + e, tn * 256 + wn * 64 + 16 * j + fr, acc[i][j][e]);
        }
    }
}

__device__ __forceinline__ int crow(int r, int hi) { return (r & 3) + 8 * (r >> 2) + 4 * hi; }
__device__ __forceinline__ void ph_attn_simple(Ctx& C) {
    const bf16* QH = WSP(bf16, WS_QH); const bf16* KH = WSP(bf16, WS_KH); const bf16* VT = WSP(bf16, WS_VT); const float* BK = WSP(float, WS_BK); bf16* AO = WSP(bf16, WS_AO);
    LAS float* wl = (LAS float*)C.lds + C.wave * 64;
    const int c32 = C.lane & 31, hi = C.lane >> 5;
    constexpr float C2 = 1.4426950408889634f * ATT_SCALE;
    const int gw = blockIdx.x * NWAVES + C.wave, NGW = C.G * NWAVES;
    for (int u = gw; u < NH * 256; u += NGW) {
        const int h = u & 15, idx = u >> 4, half = idx >> 7, qb = half ? (idx & 127) : 255 - (idx & 127);
        const int q0 = 32 * qb;
        const bf16* Qp = QH + ((size_t)h * S + q0 + c32) * HD + 8 * hi;
        bf16x8 qf[8];
#pragma unroll
        for (int d0 = 0; d0 < 8; ++d0) qf[d0] = *(const bf16x8*)(Qp + 16 * d0);
        f32x16 o[4];
#pragma unroll
        for (int d = 0; d < 4; ++d)
#pragma unroll
            for (int r = 0; r < 16; ++r) o[d][r] = 0.f;
        float m_run = -1e30f, l_run = 0.f;
        for (int jt = 0; jt <= qb; ++jt) {
            const int k0 = 32 * jt;
            f32x16 p;
#pragma unroll
            for (int r = 0; r < 16; ++r) p[r] = 0.f;
            const bf16* Kp = KH + ((size_t)h * S + k0 + c32) * HD + 8 * hi;
#pragma unroll
            for (int d0 = 0; d0 < 8; ++d0) { const bf16x8 kf = *(const bf16x8*)(Kp + 16 * d0); p = __builtin_amdgcn_mfma_f32_32x32x16_bf16(kf, qf[d0], p, 0, 0, 0); }
            float mx = -__builtin_inff();
#pragma unroll
            for (int r = 0; r < 16; ++r) { const int key = k0 + crow(r, hi); float sv = (p[r] + BK[(size_t)h * S + key]) * C2; if (key > q0 + c32) sv = -__builtin_inff(); p[r] = sv; mx = fmaxf(mx, sv); }
            mx = fmaxf(mx, __shfl_xor(mx, 32));
            const float m_new = fmaxf(m_run, mx), alpha = exp2f(m_run - m_new); m_run = m_new;
            float ps = 0.f;
#pragma unroll
            for (int r = 0; r < 16; ++r) { p[r] = exp2f(p[r] - m_new); ps += p[r]; }
            ps += __shfl_xor(ps, 32);
            l_run = l_run * alpha + ps;
            if (hi == 0) wl[c32] = alpha;
            LDS_WAIT(); asm volatile("" ::: "memory");
#pragma unroll
            for (int r = 0; r < 16; ++r) { const float a = wl[crow(r, hi)];
#pragma unroll
                for (int d = 0; d < 4; ++d) o[d][r] *= a; }
            LDS_WAIT(); asm volatile("" ::: "memory");
            bf16x8 pa[2];
#pragma unroll
            for (int ks = 0; ks < 2; ++ks) { u32x4 w; w.x = cvt_pk_bf16(p[8 * ks + 0], p[8 * ks + 1]); w.y = cvt_pk_bf16(p[8 * ks + 2], p[8 * ks + 3]); w.z = cvt_pk_bf16(p[8 * ks + 4], p[8 * ks + 5]); w.w = cvt_pk_bf16(p[8 * ks + 6], p[8 * ks + 7]); pa[ks] = *reinterpret_cast<bf16x8*>(&w); }
#pragma unroll
            for (int d = 0; d < 4; ++d) { const bf16* vp = VT + ((size_t)h * HD + 32 * d + c32) * S + k0 + 4 * hi;
#pragma unroll
                for (int ks = 0; ks < 2; ++ks) { const s16x4 v0 = *(const s16x4*)(vp + 16 * ks), v1 = *(const s16x4*)(vp + 16 * ks + 8);
                    const bf16x8 vb = {v0[0], v0[1], v0[2], v0[3], v1[0], v1[1], v1[2], v1[3]};
                    o[d] = __builtin_amdgcn_mfma_f32_32x32x16_bf16(pa[ks], vb, o[d], 0, 0, 0); } }
        }
        if (hi == 0) wl[c32] = 1.0f / l_run;
        LDS_WAIT(); asm volatile("" ::: "memory");
#pragma unroll
        for (int r = 0; r < 16; ++r) { const int qr = crow(r, hi); const float il = wl[qr];
#pragma unroll
            for (int d = 0; d < 4; ++d) AO[(size_t)(q0 + qr) * FW + h * HD + 32 * d + c32] = f2bf(o[d][r] * il); }
        LDS_WAIT(); asm volatile("" ::: "memory");
    }
}

struct EZs { bf16 *QH, *VT, *PP, *GA, *GP;
    __device__ __forceinline__ void operator()(int row, int col, float v) const {
        if (col < 6144) { const int part = col >> 11, h = (col & 2047) >> 7, d = col & 127; bf16* dst = QH + (size_t)part * (16u << 20); const bf16 b = f2bf(v);
            dst[((size_t)h * S + row) * HD + d] = b; if (part == 2) VT[((size_t)h * HD + d) * S + row] = b; }
        else if (col < 8192) PP[(size_t)row * PW + (col - 6144)] = f2bf(v);
        else if (col < 12288) GA[(size_t)row * D + (col - 8192)] = f2bf(sigmoidf_(v));
        else GP[(size_t)row * D + (col - 12288)] = f2bf(sigmoidf_(v)); } };
struct ETs { const bf16* GP; float* T;
    __device__ __forceinline__ void operator()(int row, int col, float v) const { T[(size_t)row * D + col] = bf2f(GP[(size_t)row * D + col]) * v; } };
struct EMs { const bf16* GA; const float* T; bf16* MX;
    __device__ __forceinline__ void operator()(int row, int col, float v) const { MX[(size_t)row * D + col] = f2bf(bf2f(GA[(size_t)row * D + col]) * v + T[(size_t)row * D + col]); } };
struct EYs { const float* base; const float* gate; float* Y;
    __device__ __forceinline__ void operator()(int row, int col, float v) const { Y[(size_t)row * D + col] = ALPHA * base[(size_t)row * D + col] + gate[col] * v; } };
struct EGUs { bf16* ACT;
    __device__ __forceinline__ void operator()(int row, int j, float g, float up) const { ACT[(size_t)row * FFN + j] = f2bf(g / (1.0f + __expf(-g)) * up); } };

namespace pg8 {
constexpr int BM = 256, BK = 64, HALF = 128, HTB = HALF * BK * 2, STAGE_BYTES = 8 * HTB, NXCD = 8, WGM = 8;
__host__ __device__ __forceinline__ int lds_byte(int r, int c) { const int st = (r >> 4) * 2 + (c >> 5), rr = r & 15, cc = c & 31, ob = rr * 64 + cc * 2; return st * 1024 + (ob ^ (((ob >> 9) & 1) << 5)); }
__host__ __device__ __forceinline__ void stage_rc(int b, int& R, int& C) { const int st = b / 1024, sb = b % 1024, swz = sb ^ (((sb >> 9) & 1) << 5); R = (st >> 1) * 16 + swz / 64; C = (st & 1) * 32 + (swz % 64) / 2; }
__host__ __device__ __forceinline__ int perm32(int rho) { const int n = rho >> 4, i = rho & 15; return 8 * (i >> 2) + 4 * n + (i & 3); }
struct Unit { int pm, pn; };
struct Gemm { const bf16* A; const bf16* Bt; int M, N, K, lda, grp_tiles, grp_off; };
struct StaticOrder {
    int nM, nN, nwg, G, c;
    __host__ __device__ void init(int M, int N, int G_, int c_) { nM = M / BM; nN = N / BM; nwg = nM * nN; G = G_; c = c_; }
    __host__ __device__ bool next(int i, Unit& u) const {
        const long L = (long)i * G + c; if (L >= nwg) return false;
        int wgid = (int)L; { const int q = nwg / NXCD, r = nwg % NXCD, xcd = wgid % NXCD, off = wgid / NXCD; wgid = (xcd < r ? xcd * (q + 1) : r * (q + 1) + (xcd - r) * q) + off; }
        const int nig = WGM * nN, gid = wgid / nig, fm = gid * WGM, gsz = (nM - fm) < WGM ? (nM - fm) : WGM;
        u.pm = fm + ((wgid % nig) % gsz); u.pn = (wgid % nig) / gsz; return true;
    }
    __device__ __forceinline__ void a_ready(const Unit&) const {}
    __device__ __forceinline__ void done(const Unit&) const {}
};
template <class Epi, class Sched, bool ALIGN_EPI = false, bool SP2 = false>
__device__ __forceinline__ void gemm_phase(LAS unsigned char* lds, const Gemm g, const Sched& S, const Epi& E) {
    const int tid = opaque_tid(), wid = __builtin_amdgcn_readfirstlane(tid >> 6), lane = tid & 63, wr = wid >> 2, wc = wid & 3, fr = lane & 15, fq = lane >> 4;
    const int K = g.K, nt = K / BK, lda = g.lda;
    unsigned voffA[2], voffB[2];
#pragma unroll
    for (int i = 0; i < 2; ++i) { int R, Cc; stage_rc(tid * 16 + i * 8192, R, Cc); const int Rb = Epi::PERM ? ((R & ~31) + perm32(R & 31)) : R;
        voffA[i] = (unsigned)(R * lda + Cc) * 2u; voffB[i] = (unsigned)(Rb * K + Cc) * 2u; }
    const size_t kstep = (size_t)(BK * 2);
    const size_t hstepA = (size_t)HALF * lda * 2, hstepB = (size_t)HALF * K * 2;
    const size_t tstepA = 2 * hstepA, tstepB = 2 * hstepB;
    const unsigned ldsw = (unsigned)wid * 1024u;
    const int aoff = lds_byte(wr * 64 + fr, fq * 8), boff = lds_byte(wc * 32 + fr, fq * 8);
#define PG8_SA(b, h) (((b) * 2 + (h)) * HTB)
#define PG8_SB(b, h) ((4 + (b) * 2 + (h)) * HTB)
#define PG8_STAGE(bufoff, gbase, voff) do { _Pragma("unroll") for (int _i = 0; _i < 2; ++_i) \
        __builtin_amdgcn_global_load_lds((const unsigned*)((const char*)(gbase) + (voff)[_i]), (LAS unsigned*)(lds + (bufoff) + ldsw + _i * 8192), 16, 0, 0); } while (0)
#define PG8_LDA(dst, b, h) do { _Pragma("unroll") for (int m = 0; m < 4; ++m) _Pragma("unroll") for (int k = 0; k < 2; ++k) dst[m][k] = *(const LAS bf16x8*)(lds + PG8_SA(b, h) + aoff + m * 2048 + k * 1024); } while (0)
#define PG8_LDB(dst, b, h) do { _Pragma("unroll") for (int n = 0; n < 2; ++n) _Pragma("unroll") for (int k = 0; k < 2; ++k) dst[n][k] = *(const LAS bf16x8*)(lds + PG8_SB(b, h) + boff + n * 2048 + k * 1024); } while (0)
#define PG8_MMA(ai, bj, At, Bt) do { __builtin_amdgcn_s_setprio(1); _Pragma("unroll") for (int m = 0; m < 4; ++m) _Pragma("unroll") for (int n = 0; n < 2; ++n) _Pragma("unroll") for (int k = 0; k < 2; ++k) \
        acc[ai][bj][m][n] = __builtin_amdgcn_mfma_f32_16x16x32_bf16(Bt[n][k], At[m][k], acc[ai][bj][m][n], 0, 0, 0); __builtin_amdgcn_s_setprio(0); } while (0)
#define PG8_WAIT_V(n) asm volatile("s_waitcnt vmcnt(" #n ")" ::: "memory")
#define PG8_WAIT_L(n) asm volatile("s_waitcnt lgkmcnt(" #n ")" ::: "memory")
#define PG8_BAR __builtin_amdgcn_s_barrier()
#define PG8_SCHED __builtin_amdgcn_sched_barrier(0)
#define PG8_ABASE(u) ((const char*)g.A + (size_t)(u).pm * tstepA + (size_t)((u).pn / g.grp_tiles) * g.grp_off * 2)
    Unit cur, nxt; int ui = 0;
    if (!S.next(0, cur)) return;
    f32x4 acc[2][2][4][2];
#pragma unroll
    for (int a = 0; a < 2; ++a)
#pragma unroll
        for (int b = 0; b < 2; ++b)
#pragma unroll
            for (int m = 0; m < 4; ++m)
#pragma unroll
                for (int n = 0; n < 2; ++n) acc[a][b][m][n] = (f32x4){0.f, 0.f, 0.f, 0.f};
    bf16x8 At[4][2], B0[2][2], B1[2][2];
    const char* cA = PG8_ABASE(cur); const char* cB = (const char*)g.Bt + (size_t)cur.pn * tstepB;
    S.a_ready(cur);
    if constexpr (SP2) {
        PG8_STAGE(PG8_SB(0, 0), cB, voffB); PG8_STAGE(PG8_SB(0, 1), cB + hstepB, voffB); PG8_STAGE(PG8_SA(0, 0), cA, voffA); PG8_STAGE(PG8_SA(0, 1), cA + hstepA, voffA);
        if (wr == 1) PG8_BAR;
        PG8_WAIT_V(2); PG8_BAR;
        PG8_STAGE(PG8_SB(1, 0), cB + kstep, voffB); PG8_STAGE(PG8_SA(1, 0), cA + kstep, voffA); PG8_STAGE(PG8_SB(1, 1), cB + hstepB + kstep, voffB);
        PG8_WAIT_V(6); PG8_BAR;
    } else {
        PG8_STAGE(PG8_SB(0, 0), cB, voffB); PG8_STAGE(PG8_SA(0, 0), cA, voffA); PG8_STAGE(PG8_SB(0, 1), cB + hstepB, voffB); PG8_STAGE(PG8_SA(0, 1), cA + hstepA, voffA);
        if (wr == 1) PG8_BAR;
        PG8_WAIT_V(4); PG8_BAR;
        PG8_STAGE(PG8_SB(1, 0), cB + kstep, voffB); PG8_STAGE(PG8_SA(1, 0), cA + kstep, voffA); PG8_STAGE(PG8_SB(1, 1), cB + hstepB + kstep, voffB);
        PG8_WAIT_V(6); PG8_BAR;
    }
    for (;;) {
        const bool has_next = S.next(ui + 1, nxt);
        const char* nA = has_next ? PG8_ABASE(nxt) : cA; const char* nB = has_next ? (const char*)g.Bt + (size_t)nxt.pn * tstepB : cB;
        for (int t = 0; t < nt; t += 2) {
            const bool last = (t == nt - 2);
            const char* a1 = cA + (size_t)(t + 1) * kstep;
            const char* a2 = last ? nA : cA + (size_t)(t + 2) * kstep; const char* b2 = last ? nB : cB + (size_t)(t + 2) * kstep;
            const char* a3 = a2 + kstep; const char* b3 = b2 + kstep;
            if (last && has_next) S.a_ready(nxt);
            if constexpr (SP2) {
            PG8_LDB(B0, 0, 0); PG8_LDB(B1, 0, 1); PG8_SCHED; PG8_LDA(At, 0, 0); PG8_STAGE(PG8_SA(1, 1), a1 + hstepA, voffA);
            PG8_WAIT_V(8); PG8_WAIT_L(0); PG8_BAR; PG8_MMA(0, 0, At, B0); PG8_MMA(0, 1, At, B1); PG8_BAR; PG8_SCHED;
            PG8_LDA(At, 0, 1); PG8_STAGE(PG8_SB(0, 0), b2, voffB); PG8_STAGE(PG8_SB(0, 1), b2 + hstepB, voffB); PG8_STAGE(PG8_SA(0, 0), a2, voffA);
            PG8_WAIT_V(8); PG8_WAIT_L(0); PG8_BAR; PG8_MMA(1, 0, At, B0); PG8_MMA(1, 1, At, B1); PG8_BAR; PG8_SCHED;
            PG8_LDB(B0, 1, 0); PG8_LDB(B1, 1, 1); PG8_SCHED; PG8_LDA(At, 1, 0); PG8_STAGE(PG8_SA(0, 1), a2 + hstepA, voffA);
            PG8_WAIT_V(8); PG8_WAIT_L(0); PG8_BAR; PG8_MMA(0, 0, At, B0); PG8_MMA(0, 1, At, B1); PG8_BAR; PG8_SCHED;
            PG8_LDA(At, 1, 1); PG8_STAGE(PG8_SB(1, 0), b3, voffB); PG8_STAGE(PG8_SB(1, 1), b3 + hstepB, voffB); PG8_STAGE(PG8_SA(1, 0), a3, voffA);
            PG8_WAIT_V(8); PG8_WAIT_L(0); PG8_BAR; PG8_MMA(1, 0, At, B0); PG8_MMA(1, 1, At, B1); PG8_BAR; PG8_SCHED;
            } else {
            PG8_LDB(B0, 0, 0); PG8_SCHED; PG8_LDA(At, 0, 0); PG8_STAGE(PG8_SA(1, 1), a1 + hstepA, voffA);
            PG8_WAIT_L(8); PG8_BAR; PG8_WAIT_L(0); PG8_MMA(0, 0, At, B0); PG8_BAR; PG8_SCHED;
            PG8_LDB(B1, 0, 1); PG8_STAGE(PG8_SB(0, 0), b2, voffB);
            PG8_BAR; PG8_WAIT_L(0); PG8_MMA(0, 1, At, B1); PG8_BAR;
            PG8_LDA(At, 0, 1); PG8_STAGE(PG8_SA(0, 0), a2, voffA);
            PG8_BAR; PG8_WAIT_L(0); PG8_MMA(1, 0, At, B0); PG8_BAR; PG8_SCHED;
            PG8_STAGE(PG8_SB(0, 1), b2 + hstepB, voffB);
            PG8_WAIT_V(6); PG8_BAR; PG8_MMA(1, 1, At, B1); PG8_BAR;
            PG8_LDB(B0, 1, 0); PG8_SCHED; PG8_LDA(At, 1, 0); PG8_STAGE(PG8_SA(0, 1), a2 + hstepA, voffA);
            PG8_WAIT_L(8); PG8_BAR; PG8_WAIT_L(0); PG8_MMA(0, 0, At, B0); PG8_BAR; PG8_SCHED;
            PG8_LDB(B1, 1, 1); PG8_STAGE(PG8_SB(1, 0), b3, voffB);
            PG8_BAR; PG8_WAIT_L(0); PG8_MMA(0, 1, At, B1); PG8_BAR;
            PG8_LDA(At, 1, 1); PG8_STAGE(PG8_SA(1, 0), a3, voffA);
            PG8_BAR; PG8_WAIT_L(0); PG8_MMA(1, 0, At, B0); PG8_BAR; PG8_SCHED;
            PG8_STAGE(PG8_SB(1, 1), b3 + hstepB, voffB);
            PG8_WAIT_V(6); PG8_BAR; PG8_MMA(1, 1, At, B1); PG8_BAR;
            }
        }
        if constexpr (ALIGN_EPI) { if (wr == 0) PG8_BAR; }
        E(acc, cur, wr, wc, fr, fq); S.done(cur);
        if (!has_next) break;
#pragma unroll
        for (int a = 0; a < 2; ++a)
#pragma unroll
            for (int b = 0; b < 2; ++b)
#pragma unroll
                for (int m = 0; m < 4; ++m)
#pragma unroll
                    for (int n = 0; n < 2; ++n) acc[a][b][m][n] = (f32x4){0.f, 0.f, 0.f, 0.f};
        cur = nxt; cA = nA; cB = nB; ++ui;
        if constexpr (ALIGN_EPI) { if (wr == 1) PG8_BAR; }
    }
    PG8_WAIT_V(0);
    if constexpr (!ALIGN_EPI) { if (wr == 0) PG8_BAR; }
    PG8_BAR;
#undef PG8_SA
#undef PG8_SB
#undef PG8_STAGE
#undef PG8_LDA
#undef PG8_LDB
#undef PG8_MMA
#undef PG8_WAIT_V
#undef PG8_WAIT_L
#undef PG8_BAR
#undef PG8_SCHED
#undef PG8_ABASE
}
__device__ __forceinline__ u32x4 pack8(const f32x4 v0, const f32x4 v1) { u32x4 w; w.x = cvt_pk_bf16(v0[0], v0[1]); w.y = cvt_pk_bf16(v0[2], v0[3]); w.z = cvt_pk_bf16(v1[0], v1[1]); w.w = cvt_pk_bf16(v1[2], v1[3]); return w; }
__device__ __forceinline__ f32x4 sig4(const f32x4 v) { f32x4 r; r.x = __builtin_amdgcn_rcpf(1.0f + __builtin_amdgcn_exp2f(-1.4426950408889634f * v.x)); r.y = __builtin_amdgcn_rcpf(1.0f + __builtin_amdgcn_exp2f(-1.4426950408889634f * v.y));
    r.z = __builtin_amdgcn_rcpf(1.0f + __builtin_amdgcn_exp2f(-1.4426950408889634f * v.z)); r.w = __builtin_amdgcn_rcpf(1.0f + __builtin_amdgcn_exp2f(-1.4426950408889634f * v.w)); return r; }
__device__ __forceinline__ void bf8_to_f32(const u32x4 w, f32x4& lo, f32x4& hi) { lo.x = __uint_as_float(w.x << 16); lo.y = __uint_as_float(w.x & 0xffff0000u); lo.z = __uint_as_float(w.y << 16); lo.w = __uint_as_float(w.y & 0xffff0000u);
    hi.x = __uint_as_float(w.z << 16); hi.y = __uint_as_float(w.z & 0xffff0000u); hi.z = __uint_as_float(w.w << 16); hi.w = __uint_as_float(w.w & 0xffff0000u); }
struct EpiZ { static constexpr bool PERM = true;
    unsigned char* ws; bf16* VT; unsigned* norm;
    __device__ __forceinline__ void operator()(const f32x4 (&acc)[2][2][4][2], const Unit& u, int wr, int wc, int fr, int fq) const {
        const int row0 = u.pm * BM + wr * 64 + fr, cw = wc * 32 + 8 * fq; bf16* QH = (bf16*)(ws + WS_QH);
        if (u.pn < 24) {
            const int part = u.pn >> 3, h0 = (u.pn & 7) * 2;
            if (part < 2) {
#pragma unroll
                for (int bj = 0; bj < 2; ++bj) { float wmax = 0.f;
#pragma unroll
                    for (int ai = 0; ai < 2; ++ai)
#pragma unroll
                        for (int m = 0; m < 4; ++m) { const f32x4 a = acc[ai][bj][m][0], b = acc[ai][bj][m][1];
                            float ss = (a.x * a.x + a.y * a.y) + (a.z * a.z + a.w * a.w) + (b.x * b.x + b.y * b.y) + (b.z * b.z + b.w * b.w);
                            ss += __shfl_xor(ss, 16); ss += __shfl_xor(ss, 32); wmax = fmaxf(wmax, ss); }
#pragma unroll
                    for (int o = 1; o < 16; o <<= 1) wmax = fmaxf(wmax, __shfl_xor(wmax, o));
                    if (fr == 0 && fq == 0) atomicMax(norm + (part * 16 + h0 + bj) * 4 + wc, __float_as_uint(wmax)); }
            }
#pragma unroll
            for (int ai = 0; ai < 2; ++ai)
#pragma unroll
                for (int m = 0; m < 4; ++m) { const int row = row0 + ai * HALF + m * 16;
#pragma unroll
                    for (int bj = 0; bj < 2; ++bj) { const u32x4 w = pack8(acc[ai][bj][m][0], acc[ai][bj][m][1]);
                        *(u32x4*)(QH + (size_t)part * (16u << 20) + ((size_t)(h0 + bj) * S + row) * HD + cw) = w;
                        if (VT != nullptr && part == 2) { const unsigned ww[4] = {w.x, w.y, w.z, w.w};
#pragma unroll
                            for (int e = 0; e < 8; ++e) VT[((size_t)(h0 + bj) * HD + cw + e) * S + row] = (bf16)((ww[e >> 1] >> (16 * (e & 1))) & 0xffffu); } } }
        } else {
            const bool sg = u.pn >= 32; const int ld = u.pn < 32 ? PW : D, ct = u.pn < 32 ? u.pn - 24 : (u.pn < 48 ? u.pn - 32 : u.pn - 48);
            bf16* dst = (bf16*)(ws + (u.pn < 32 ? WS_PP : (u.pn < 48 ? WS_GA : WS_GP)));
#pragma unroll
            for (int ai = 0; ai < 2; ++ai)
#pragma unroll
                for (int m = 0; m < 4; ++m) { bf16* rowp = dst + (size_t)(row0 + ai * HALF + m * 16) * ld + ct * BM + cw;
#pragma unroll
                    for (int bj = 0; bj < 2; ++bj) { f32x4 v0 = acc[ai][bj][m][0], v1 = acc[ai][bj][m][1]; if (sg) { v0 = sig4(v0); v1 = sig4(v1); }
                        *(u32x4*)(rowp + bj * HALF) = pack8(v0, v1); } }
        }
    }
};
struct EpiT { static constexpr bool PERM = false;
    const bf16* GP; float* T;
    __device__ __forceinline__ void operator()(const f32x4 (&acc)[2][2][4][2], const Unit& u, int wr, int wc, int fr, int fq) const {
        const int row0 = u.pm * BM + wr * 64 + fr, col0 = u.pn * BM + wc * 32 + 4 * fq;
#pragma unroll
        for (int ai = 0; ai < 2; ++ai)
#pragma unroll
            for (int m = 0; m < 4; ++m) { const size_t off = (size_t)(row0 + ai * HALF + m * 16) * D + col0;
#pragma unroll
                for (int bj = 0; bj < 2; ++bj)
#pragma unroll
                    for (int n = 0; n < 2; ++n) { const u32x2 gw = *(const u32x2*)(GP + off + bj * HALF + n * 16); f32x4 gv; gv.x = __uint_as_float(gw.x << 16); gv.y = __uint_as_float(gw.x & 0xffff0000u); gv.z = __uint_as_float(gw.y << 16); gv.w = __uint_as_float(gw.y & 0xffff0000u);
                        *(f32x4*)(T + off + bj * HALF + n * 16) = acc[ai][bj][m][n] * gv; } }
    }
};
struct EpiM { static constexpr bool PERM = true;
    const bf16* GA; const float* T; bf16* MX;
    __device__ __forceinline__ void operator()(const f32x4 (&acc)[2][2][4][2], const Unit& u, int wr, int wc, int fr, int fq) const {
        const int row0 = u.pm * BM + wr * 64 + fr, col0 = u.pn * BM + wc * 32 + 8 * fq;
#pragma unroll
        for (int ai = 0; ai < 2; ++ai)
#pragma unroll
            for (int m = 0; m < 4; ++m) { const size_t off = (size_t)(row0 + ai * HALF + m * 16) * D + col0;
#pragma unroll
                for (int bj = 0; bj < 2; ++bj) { f32x4 g0, g1; bf8_to_f32(*(const u32x4*)(GA + off + bj * HALF), g0, g1);
                    const f32x4 t0 = *(const f32x4*)(T + off + bj * HALF), t1 = *(const f32x4*)(T + off + bj * HALF + 4);
                    *(u32x4*)(MX + off + bj * HALF) = pack8(acc[ai][bj][m][0] * g0 + t0, acc[ai][bj][m][1] * g1 + t1); } }
    }
};
struct EpiY { static constexpr bool PERM = false;
    const float* base; const float* gate; float* Y;
    __device__ __forceinline__ void operator()(const f32x4 (&acc)[2][2][4][2], const Unit& u, int wr, int wc, int fr, int fq) const {
        const int row0 = u.pm * BM + wr * 64 + fr, col0 = u.pn * BM + wc * 32 + 4 * fq;
        f32x4 gv[2][2];
#pragma unroll
        for (int bj = 0; bj < 2; ++bj)
#pragma unroll
            for (int n = 0; n < 2; ++n) gv[bj][n] = *(const f32x4*)(gate + col0 + bj * HALF + n * 16);
#pragma unroll
        for (int ai = 0; ai < 2; ++ai)
#pragma unroll
            for (int m = 0; m < 4; ++m) { const size_t off = (size_t)(row0 + ai * HALF + m * 16) * D + col0;
#pragma unroll
                for (int bj = 0; bj < 2; ++bj)
#pragma unroll
                    for (int n = 0; n < 2; ++n) { const f32x4 bs = *(const f32x4*)(base + off + bj * HALF + n * 16);
                        *(f32x4*)(Y + off + bj * HALF + n * 16) = bs * ALPHA + acc[ai][bj][m][n] * gv[bj][n]; } }
    }
};
struct EpiGU { static constexpr bool PERM = true;
    bf16* ACT;
    __device__ __forceinline__ void operator()(const f32x4 (&acc)[2][2][4][2], const Unit& u, int wr, int wc, int fr, int fq) const {
        const int row0 = u.pm * BM + wr * 64 + fr, j0 = u.pn * HALF + wc * 32 + 8 * fq;
#pragma unroll
        for (int ai = 0; ai < 2; ++ai)
#pragma unroll
            for (int m = 0; m < 4; ++m) { const f32x4 a0 = acc[ai][0][m][0] * sig4(acc[ai][0][m][0]) * acc[ai][1][m][0], a1 = acc[ai][0][m][1] * sig4(acc[ai][0][m][1]) * acc[ai][1][m][1];
                *(u32x4*)(ACT + (size_t)(row0 + ai * HALF + m * 16) * FFN + j0) = pack8(a0, a1); }
    }
};
}

namespace att {
constexpr int NW = 8, QBLK = 32, KVBLK = 64, QB = NW * QBLK;
constexpr int SHM_V = KVBLK * HD * 2, SHM_K = KVBLK * HD * 2;
constexpr int OFF_WS = 3 * SHM_V + 2 * SHM_K, OFF_B = OFF_WS + NW * 64 * 4, LDS_ATT = OFF_B + 2 * 256;
static_assert(LDS_ATT <= 131072, "attention LDS");
constexpr float THR = 8.f;
#define KSWZ(row, colB) ((row) * 256 + ((colB) ^ (((row) & 7) << 4)))
#define SBAR() __builtin_amdgcn_sched_barrier(0)
__device__ __forceinline__ int v_st(int k, int c) { const int kk = (k & ~0xC) | ((k & 4) << 1) | ((k & 8) >> 1); return ((kk >> 3) * 4 + (c >> 5)) * 512 + ((kk & 7) * 32 + (c & 31)) * 2; }
__device__ __forceinline__ int v_rd_base(int lane) { return ((lane & 3) << 3) | (((lane >> 2) & 3) << 6) | (((lane >> 4) & 1) << 5) | (((lane >> 5) & 1) << 8); }
constexpr int v_rd_off(int d0, int ks, int half) { return d0 * 512 + ks * 4096 + half * 2048; }
__device__ __forceinline__ bf16x8 pack8v(f32x4 a, f32x4 b) { u32x4 w = {cvt_pk_bf16(a[0], a[1]), cvt_pk_bf16(a[2], a[3]), cvt_pk_bf16(b[0], b[1]), cvt_pk_bf16(b[2], b[3])}; return *reinterpret_cast<bf16x8*>(&w); }
__device__ __forceinline__ void mask_tile(f32x16& p0, f32x16& p1, int dq) {
    const float NEG = -__builtin_inff();
#pragma unroll
    for (int r = 0; r < 16; ++r) { const int c = (r & 3) + 8 * (r >> 2); if (dq - c < 0) p0[r] = NEG; if (dq - c - 32 < 0) p1[r] = NEG; }
}
__device__ __forceinline__ void add_bias(f32x16& p0, f32x16& p1, LAS const char* bl_) {
    LAS const float* bl = (LAS const float*)bl_;
#pragma unroll
    for (int i = 0; i < 4; ++i) { const f32x4 a = *(LAS const f32x4*)(bl + 8 * i), b = *(LAS const f32x4*)(bl + 32 + 8 * i);
        p0[4 * i] += a[0]; p0[4 * i + 1] += a[1]; p0[4 * i + 2] += a[2]; p0[4 * i + 3] += a[3]; p1[4 * i] += b[0]; p1[4 * i + 1] += b[1]; p1[4 * i + 2] += b[2]; p1[4 * i + 3] += b[3]; }
}
__device__ __forceinline__ void partialSM(f32x16& p0, f32x16& p1, float& m_reg, float& mn, float& alpha) {
    float pmax = p0[0];
#pragma unroll
    for (int r = 1; r < 16; ++r) pmax = fmaxf(pmax, p0[r]);
#pragma unroll
    for (int r = 0; r < 16; ++r) pmax = fmaxf(pmax, p1[r]);
    { auto rr = __builtin_amdgcn_permlane32_swap(__float_as_uint(pmax), __float_as_uint(pmax), false, false); pmax = fmaxf(__uint_as_float(rr[0]), __uint_as_float(rr[1])); }
    constexpr float C2 = 1.4426950408889634f * ATT_SCALE;
    if (__builtin_expect(__all((pmax - m_reg) * ATT_SCALE <= THR), 1)) { mn = m_reg; alpha = 1.f; }
    else { mn = fmaxf(m_reg, pmax); alpha = __builtin_amdgcn_exp2f((m_reg - mn) * C2); m_reg = mn; }
    const float mnL = -mn * C2;
#pragma unroll
    for (int r = 0; r < 16; ++r) p0[r] = fmaf(p0[r], C2, mnL);
#pragma unroll
    for (int r = 0; r < 16; ++r) p1[r] = fmaf(p1[r], C2, mnL);
#pragma unroll
    for (int r = 0; r < 16; ++r) p0[r] = __builtin_amdgcn_exp2f(p0[r]);
}
__device__ __forceinline__ void finishSM(f32x16& p0, f32x16& p1, float alpha, float& l_reg, bf16x8& pa0, bf16x8& pa1, bf16x8& pa2, bf16x8& pa3) {
#pragma unroll
    for (int r = 0; r < 16; ++r) p1[r] = __builtin_amdgcn_exp2f(p1[r]);
    float ps = 0;
#pragma unroll
    for (int r = 0; r < 16; ++r) ps += p0[r];
#pragma unroll
    for (int r = 0; r < 16; ++r) ps += p1[r];
    { auto rr = __builtin_amdgcn_permlane32_swap(__float_as_uint(ps), __float_as_uint(ps), false, false); ps = __uint_as_float(rr[0]) + __uint_as_float(rr[1]); }
    l_reg = l_reg * alpha + ps;
#define PK4(P, B_, OUT) do { unsigned a0 = cvt_pk_bf16(P[B_+0], P[B_+1]), a1 = cvt_pk_bf16(P[B_+2], P[B_+3]);                          \
        unsigned b0 = cvt_pk_bf16(P[B_+4], P[B_+5]), b1 = cvt_pk_bf16(P[B_+6], P[B_+7]);                                             \
        auto r0 = __builtin_amdgcn_permlane32_swap(a0, b0, false, false); auto r1 = __builtin_amdgcn_permlane32_swap(a1, b1, false, false); \
        u32x4 w = {r0[0], r1[0], r0[1], r1[1]}; OUT = *reinterpret_cast<bf16x8*>(&w); } while (0)
    PK4(p0, 0, pa0); PK4(p0, 8, pa1); PK4(p1, 0, pa2); PK4(p1, 8, pa3);
#undef PK4
}
template <int KB>
__device__ __forceinline__ void qkt(f32x16& p0, f32x16& p1, LAS const char* K_lds, int r32, int hi, const bf16x8* qr) {
#pragma unroll
    for (int r = 0; r < 16; ++r) { p0[r] = 0.f; p1[r] = 0.f; }
    LAS const char* kb[4];
#pragma unroll
    for (int dd = 0; dd < 4; ++dd) kb[dd] = K_lds + KB * SHM_K + KSWZ(r32, (dd * 16 + hi * 8) * 2);
#pragma unroll
    for (int d0 = 0; d0 < 8; ++d0) { LAS const char* a = kb[d0 & 3] + (d0 >> 2) * 128;
        bf16x8 b0 = *reinterpret_cast<LAS const bf16x8*>(a);
        bf16x8 b1 = *reinterpret_cast<LAS const bf16x8*>(a + 32 * 256);
        p0 = __builtin_amdgcn_mfma_f32_32x32x16_bf16(b0, qr[d0], p0, 0, 0, 0);
        p1 = __builtin_amdgcn_mfma_f32_32x32x16_bf16(b1, qr[d0], p1, 0, 0, 0); }
}
template <int VB>
__device__ __forceinline__ void pv_tile(f32x16* o, int vb0, bf16x8 pa0, bf16x8 pa1, bf16x8 pa2, bf16x8 pa3) {
#define TRRD(dst, off) asm volatile("ds_read_b64_tr_b16 %0, %1 offset:%2" : "=&v"(dst) : "v"(vb0), "i"(off) : "memory")
#define PV_D0(d0) do { s16x4 l0, l1, l2, l3, h0, h1, h2, h3; constexpr int b_ = VB * SHM_V + v_rd_off(d0, 0, 0);    \
        TRRD(l0, b_); TRRD(h0, b_ + 2048); TRRD(l1, b_ + 4096); TRRD(h1, b_ + 6144); TRRD(l2, b_ + 8192); TRRD(h2, b_ + 10240); TRRD(l3, b_ + 12288); TRRD(h3, b_ + 14336); \
        asm volatile("s_waitcnt lgkmcnt(0)" ::: "memory"); SBAR();   \
        o[d0] = __builtin_amdgcn_mfma_f32_32x32x16_bf16(pa0, (bf16x8){l0[0], l0[1], l0[2], l0[3], h0[0], h0[1], h0[2], h0[3]}, o[d0], 0, 0, 0);   \
        o[d0] = __builtin_amdgcn_mfma_f32_32x32x16_bf16(pa1, (bf16x8){l1[0], l1[1], l1[2], l1[3], h1[0], h1[1], h1[2], h1[3]}, o[d0], 0, 0, 0);   \
        o[d0] = __builtin_amdgcn_mfma_f32_32x32x16_bf16(pa2, (bf16x8){l2[0], l2[1], l2[2], l2[3], h2[0], h2[1], h2[2], h2[3]}, o[d0], 0, 0, 0);   \
        o[d0] = __builtin_amdgcn_mfma_f32_32x32x16_bf16(pa3, (bf16x8){l3[0], l3[1], l3[2], l3[3], h3[0], h3[1], h3[2], h3[3]}, o[d0], 0, 0, 0); } while (0)
    PV_D0(0); PV_D0(1); PV_D0(2); PV_D0(3);
#undef PV_D0
#undef TRRD
}
struct BlockRef { const bf16* Q; const bf16* K; const bf16* V; const float* B; bf16* O; int P0; };
#define VMW() asm volatile("s_waitcnt vmcnt(0)" ::: "memory")
__device__ __forceinline__ void block(const BlockRef& cur, LAS char* lds, const int j0, const int NT, float* part) {
    const int tid = opaque_tid(), wid = __builtin_amdgcn_readfirstlane(tid >> 6), lane = tid & 63, r32 = lane & 31, hi = lane >> 5;
    const int qlo = cur.P0 + wid * QBLK, qm = qlo + r32 - 4 * hi;
    LAS char* V_lds = lds; LAS char* K_lds = lds + 3 * SHM_V; LAS char* B_lds = lds + OFF_B;
    LAS float* wsl = (LAS float*)(lds + OFF_WS) + wid * 64; LAS float* li_l = wsl; LAS float* al_l = wsl + 32;
    int kofs, vofs;
    { const int q = wid * 64 + lane;
        { const int row = q >> 4, cp = q & 15, c = cp ^ (row & 7); kofs = row * HD + c * 8; }
        { const int st = q >> 5, kkl = (q >> 2) & 7, cq = q & 3, kk = (st >> 2) * 8 + kkl, c = (st & 3) * 32 + cq * 8, k = (kk & ~0xC) | ((kk & 4) << 1) | ((kk & 8) >> 1); vofs = k * HD + c; } }
    const bf16* Kh = cur.K; const bf16* Vh = cur.V; const float* Bh = cur.B;
#define DMA_TILE(t_, kb_, vs_) do { const int k0_ = (j0 + (t_)) * KVBLK;                                                                                               \
        if (wid == 0) __builtin_amdgcn_global_load_lds((const unsigned*)(Bh + k0_ + lane), (LAS unsigned*)(B_lds + (kb_) * 256), 4, 0, 0);                 \
        _Pragma("unroll") for (int j_ = 0; j_ < 2; ++j_) __builtin_amdgcn_global_load_lds((const unsigned*)(Kh + (size_t)(k0_ + 32 * j_) * HD + kofs), (LAS unsigned*)(K_lds + (kb_) * SHM_K + (j_ * 8 + wid) * 1024), 16, 0, 0); \
        _Pragma("unroll") for (int j_ = 0; j_ < 2; ++j_) __builtin_amdgcn_global_load_lds((const unsigned*)(Vh + (size_t)(k0_ + 32 * j_) * HD + vofs), (LAS unsigned*)(V_lds + (vs_) * SHM_V + (j_ * 8 + wid) * 1024), 16, 0, 0); } while (0)
    DMA_TILE(0, 0, 0);
    bf16x8 qr[8];
#pragma unroll
    for (int d0 = 0; d0 < 8; ++d0) qr[d0] = *(const bf16x8*)(cur.Q + (size_t)(wid * QBLK + r32) * HD + d0 * 16 + hi * 8);
    float m_reg = -1e30f, l_reg = 0; f32x16 o[4];
#pragma unroll
    for (int d = 0; d < 4; ++d)
#pragma unroll
        for (int r = 0; r < 16; ++r) o[d][r] = 0.f;
    const int vb0 = (int)(unsigned)(uintptr_t)V_lds + v_rd_base(lane);
#define RESC(a) do { if (__any((a) < 1.f)) { if (hi == 0) al_l[r32] = (a); asm volatile("s_waitcnt lgkmcnt(0)" ::: "memory");              \
                     _Pragma("unroll") for (int d_ = 0; d_ < 4; ++d_) _Pragma("unroll") for (int r = 0; r < 16; ++r) o[d_][r] *= al_l[crow(r, hi)]; } } while (0)
#define KBASE(t) ((j0 + (t)) * KVBLK)
#define MASKT(P0_, P1_, t, kb_) do { const int kbs_ = KBASE(t); add_bias(P0_, P1_, B_lds + (kb_) * 256 + 16 * hi); if (kbs_ + KVBLK - 1 > qlo) mask_tile(P0_, P1_, qm - kbs_); } while (0)
    f32x16 pA0, pA1, pB0, pB1; float mnA, mnB, alA, alB; bf16x8 pa0, pa1, pa2, pa3;
    VMW(); __syncthreads();
    if (NT > 1) DMA_TILE(1, 1, 1);
    SBAR(); qkt<0>(pA0, pA1, K_lds, r32, hi, qr);
    MASKT(pA0, pA1, 0, 0); partialSM(pA0, pA1, m_reg, mnA, alA);
    VMW(); __syncthreads();
    int vs = 0;
#define HALF_STEP(PX0, PX1, mnX, alX, PY0, PY1, alY, t, KB) do {                                                      \
        SBAR(); qkt<KB>(PX0, PX1, K_lds, r32, hi, qr);                                             \
        finishSM(PY0, PY1, alY, l_reg, pa0, pa1, pa2, pa3); SBAR();                                                           \
        if ((t) + 1 < NT) { DMA_TILE((t) + 1, (KB) ^ 1, (vs == 0 ? 2 : vs - 1)); SBAR(); }                                               \
        pv_tile<0>(o, vb0 + vs * SHM_V, pa0, pa1, pa2, pa3); MASKT(PX0, PX1, (t), KB); partialSM(PX0, PX1, m_reg, mnX, alX);                                        \
        RESC(alX); VMW(); __syncthreads(); vs = (vs == 2 ? 0 : vs + 1); } while (0)
    for (int t = 1; t + 1 < NT; t += 2) {
        HALF_STEP(pB0, pB1, mnB, alB, pA0, pA1, alA, t, 1);
        HALF_STEP(pA0, pA1, mnA, alA, pB0, pB1, alB, t + 1, 0);
    }
    const bool even = (NT & 1) == 0;
    if (even) { SBAR(); qkt<1>(pB0, pB1, K_lds, r32, hi, qr); SBAR(); }
    finishSM(pA0, pA1, alA, l_reg, pa0, pa1, pa2, pa3); SBAR();
    pv_tile<0>(o, vb0 + vs * SHM_V, pa0, pa1, pa2, pa3);
    if (even) { vs = (vs == 2 ? 0 : vs + 1); MASKT(pB0, pB1, NT - 1, 1); partialSM(pB0, pB1, m_reg, mnB, alB); RESC(alB);
        finishSM(pB0, pB1, alB, l_reg, pa0, pa1, pa2, pa3); SBAR(); pv_tile<0>(o, vb0 + vs * SHM_V, pa0, pa1, pa2, pa3); }
    SBAR();
    if (part != nullptr) {
        if (hi == 0) { part[32768 + wid * QBLK + r32] = m_reg; part[32768 + 256 + wid * QBLK + r32] = l_reg; }
        float* po = part + (size_t)(wid * QBLK) * HD + r32; asm volatile("" : "+v"(po));
#pragma unroll
        for (int r = 0; r < 16; ++r)
#pragma unroll
            for (int d0 = 0; d0 < 4; ++d0) *(GAS float*)(po + crow(r, hi) * HD + d0 * 32) = o[d0][r];
    } else {
    if (hi == 0) li_l[r32] = l_reg; asm volatile("s_waitcnt lgkmcnt(0)" ::: "memory");
    float rli[16];
#pragma unroll
    for (int r = 0; r < 16; ++r) rli[r] = __builtin_amdgcn_rcpf(li_l[crow(r, hi)]);
    bf16* Ow = cur.O + (size_t)(wid * QBLK) * FW + r32; asm volatile("" : "+v"(Ow));
#pragma unroll
    for (int r = 0; r < 16; ++r) { const int orow = crow(r, hi);
#pragma unroll
        for (int d0 = 0; d0 < 4; ++d0) { const float v = o[d0][r] * rli[r]; const float vn = __shfl_xor(v, 1);
            if ((r32 & 1) == 0) *(GAS unsigned*)(Ow + (size_t)orow * FW + d0 * 32) = cvt_pk_bf16(v, vn); } }
    }
    __syncthreads();
#undef RESC
#undef KBASE
#undef MASKT
#undef HALF_STEP
#undef DMA_TILE
}
#undef VMW
__device__ __forceinline__ BlockRef make_ref(unsigned char* ws, int h, int qb) {
    BlockRef r; r.Q = (const bf16*)(ws + WS_QH) + ((size_t)h * S + (size_t)qb * QB) * HD; r.K = (const bf16*)(ws + WS_KH) + (size_t)h * S * HD; r.V = (const bf16*)(ws + WS_VH) + (size_t)h * S * HD;
    r.B = (const float*)(ws + WS_BK) + (size_t)h * S; r.O = (bf16*)(ws + WS_AO) + (size_t)qb * QB * FW + h * HD; r.P0 = qb * QB; return r;
}
constexpr int TMAX = ATT_TMAX;
__device__ __forceinline__ int pslot(int h, int qb, int p) { return h * 72 + (qb < 16 ? (qb - 8) * 2 : (qb < 24 ? 16 + (qb - 16) * 3 : 40 + (qb - 24) * 4)) + p; }
__device__ __forceinline__ void run_att_entry(unsigned char* ws, LAS char* lds, int h, int ent) {
    const int j0 = ent & 0xff, nt = (ent >> 8) & 0xff, qb = (ent >> 16) & 0xff, p = (ent >> 24) & 0xf, split = (ent >> 28) & 1;
    const BlockRef cur = make_ref(ws, h, qb);
    block(cur, lds, j0, nt, split ? (float*)(ws + WS_PART + (size_t)pslot(h, qb, p) * PART_BYTES) : (float*)nullptr);
}
__device__ __forceinline__ void combine_block(unsigned char* ws, int h, int qb, int tid) {
    const int jlo = ((const int*)(ws + WS_JLO))[h * 32 + qb], n = 4 * (qb + 1) - jlo, P = (n + TMAX - 1) / TMAX;
    if (P <= 1) return;
    constexpr float C2 = 1.4426950408889634f * ATT_SCALE;
    const float* base = (const float*)(ws + WS_PART + (size_t)pslot(h, qb, 0) * PART_BYTES);
    const int c4 = tid & 31;
#pragma unroll 2
    for (int rr = 0; rr < 16; ++rr) { const int row = rr * 16 + (tid >> 5);
        float mp[4], wp[4]; f32x4 ov[4]; float M = -3.0e38f;
#pragma unroll
        for (int p = 0; p < 4; ++p) if (p < P) { mp[p] = base[(size_t)p * (PART_BYTES / 4) + 32768 + row]; wp[p] = base[(size_t)p * (PART_BYTES / 4) + 32768 + 256 + row];
            ov[p] = *(const f32x4*)(base + (size_t)p * (PART_BYTES / 4) + (size_t)row * HD + 4 * c4); M = fmaxf(M, mp[p]); }
        float L = 0.f; f32x4 acc = {0.f, 0.f, 0.f, 0.f};
#pragma unroll
        for (int p = 0; p < 4; ++p) if (p < P) { const float w = exp2f((mp[p] - M) * C2); L += w * wp[p]; acc += ov[p] * w; }
        acc = acc * (1.0f / L); u32x2 w; w.x = cvt_pk_bf16(acc.x, acc.y); w.y = cvt_pk_bf16(acc.z, acc.w);
        *(u32x2*)((bf16*)(ws + WS_AO) + (size_t)(qb * QB + row) * FW + h * HD + 4 * c4) = w; }
}
#undef KSWZ
#undef SBAR
}

typedef GAS unsigned gu32;
#define RLX_AGENT __ATOMIC_RELAXED, __HIP_MEMORY_SCOPE_AGENT
#define XB_TMO      128
#define XB_XCNT(j)  (256  + 64 * (j))
#define XB_XSUB(j)  (1280 + 64 * (j))
#define XB_XGEN(j)  (2304 + 64 * (j))
#define XB_TOP      3328
#define XB_TOPGEN   3392
#define XCD_BAR_WORDS 3456
#define XB_SPIN_CAP (1u << 18)

__device__ __forceinline__ unsigned xb_ld(unsigned* p)              { return __hip_atomic_load(p, __ATOMIC_RELAXED, __HIP_MEMORY_SCOPE_AGENT); }
__device__ __forceinline__ unsigned xb_add(unsigned* p, unsigned v) { return __hip_atomic_fetch_add(p, v, __ATOMIC_RELAXED, __HIP_MEMORY_SCOPE_AGENT); }
__device__ __forceinline__ unsigned xb_xcc_id() { return (unsigned)__builtin_amdgcn_s_getreg((3 << 11) | 20) & 0xFu; }
#define XB_SPIN(cond, bar) do { unsigned _sp = 0; while (cond) { __builtin_amdgcn_s_sleep(1); \
    if ((++_sp & 255u) == 0u) { if (xb_ld(&(bar)[XB_TMO])) break; if (_sp > XB_SPIN_CAP) { atomicAdd(&(bar)[XB_TMO], 1u); break; } } } } while (0)

struct XcdBarrier {
    unsigned* bar; unsigned x;
    volatile LAS unsigned* st;
};

__device__ __forceinline__ XcdBarrier xcd_barrier_post(unsigned* bar, volatile LAS unsigned* st) {
    XcdBarrier b; b.bar = bar; b.x = xb_xcc_id(); b.st = st;
    if (threadIdx.x == 0) (void)xb_add(&bar[XB_XCNT(b.x)], 1u);
    return b;
}
__device__ __forceinline__ void xcd_barrier_complete(unsigned* bar, unsigned x, unsigned& nloc, unsigned& nx) {
    const unsigned G = gridDim.x * gridDim.y * gridDim.z;
    unsigned sum, cnt, mine, sp = 0u;
    for (;;) {
        sum = 0u; cnt = 0u; mine = 0u;
#pragma unroll
        for (unsigned j = 0; j < 16; ++j) { const unsigned c = xb_ld(&bar[XB_XCNT(j)]); sum += c; cnt += (c > 0u) ? 1u : 0u; mine = (j == x) ? c : mine; }
        if (sum == G) break;
        __builtin_amdgcn_s_sleep(1);
        if ((++sp & 255u) == 0u) { if (xb_ld(&bar[XB_TMO])) break; if (sp > XB_SPIN_CAP) { atomicAdd(&bar[XB_TMO], 1u); break; } }
    }
    nloc = mine > 0u ? mine : 1u; nx = cnt > 0u ? cnt : 1u;
}

__device__ __forceinline__ void xcd_barrier(const XcdBarrier& b) {
    asm volatile("s_waitcnt vmcnt(0)" ::: "memory");
    __syncthreads();
    if (threadIdx.x == 0) {
        unsigned* bar = b.bar;
        __builtin_amdgcn_s_waitcnt(0);
        unsigned nloc = b.st[0], nx = b.st[1];
        if (nloc == 0u) { xcd_barrier_complete(bar, b.x, nloc, nx); b.st[0] = nloc; b.st[1] = nx; }
        const unsigned old = xb_add(&bar[XB_XSUB(b.x)], 1u);
        const unsigned gen = old / nloc;
        if (old + 1u == (gen + 1u) * nloc) {
            __builtin_amdgcn_fence(__ATOMIC_RELEASE, "agent");
            asm volatile("s_waitcnt vmcnt(0)" ::: "memory");
            const unsigned og = xb_add(&bar[XB_TOP], 1u);
            const unsigned tg = og / nx;
            if (og + 1u == (tg + 1u) * nx) xb_add(&bar[XB_TOPGEN], 1u);
            else XB_SPIN(xb_ld(&bar[XB_TOPGEN]) == tg, bar);
            __builtin_amdgcn_fence(__ATOMIC_ACQUIRE, "agent");
            xb_add(&bar[XB_XGEN(b.x)], 1u);
            asm volatile("s_waitcnt vmcnt(0)" ::: "memory");
        } else {
            XB_SPIN(xb_ld(&bar[XB_XGEN(b.x)]) == gen, bar);
            __builtin_amdgcn_fence(__ATOMIC_ACQUIRE, "agent");
            asm volatile("s_waitcnt vmcnt(0)" ::: "memory");
        }
    }
    __syncthreads();
}


constexpr int CONV_SLOT_ITEMS = 64, CONV_SLOTS = CI_LATE / CONV_SLOT_ITEMS;
static_assert(CI_LATE % CONV_SLOT_ITEMS == 0, "conversion slots");
__device__ __forceinline__ void ph_attn_queue(Ctx& C) {
    LAS int* qword = (LAS int*)(C.lds + 131072 + 64);
    unsigned* qbase = (unsigned*)(C.ws + WS_CTL) + CW_QCNT;
    const int* lists = (const int*)(C.ws + WS_LIST);
    const int x0 = (int)(xb_xcc_id() & 7u);
    int it = 0;
    for (int dx = 0; dx < 8; ++dx) {
        const int x = (x0 + dx) & 7, hA = 15 - x, hB = x;
        const int cA = __builtin_amdgcn_readfirstlane(lists[hA * 96]), cB = __builtin_amdgcn_readfirstlane(lists[hB * 96]);
        const int nconv = LATE_CONV_IN_QUEUE ? (CONV_SLOTS - x + 7) / 8 : 0;
        bool att_left = true, conv_left = nconv > 0;
        while (att_left || conv_left) {
            const bool want_conv = conv_left && (!att_left || (it % 3) == 2); ++it;
            if (C.tid == 0) qword[0] = (int)__hip_atomic_fetch_add(qbase + 128 * x + (want_conv ? 64 : 0), 1u, __ATOMIC_RELAXED, __HIP_MEMORY_SCOPE_AGENT);
            __syncthreads();
            const int idx = __builtin_amdgcn_readfirstlane(qword[0]);
            __syncthreads();
            if (want_conv) {
                if (idx >= nconv) { conv_left = false; continue; }
                const int cs = idx * 8 + x; LAS char* scr = (LAS char*)(C.lds + C.wave * CONV_SCR); const int ln = opaque_tid() & 63;
                for (int i = 0; i < CONV_SLOT_ITEMS / NWAVES; ++i) conv_late_item(C, cs * CONV_SLOT_ITEMS + i * NWAVES + C.wave, scr, ln);
                __syncthreads();
            } else {
                if (idx >= cA + cB) { att_left = false; continue; }
                const int h = idx < cA ? hA : hB, ent = __builtin_amdgcn_readfirstlane(lists[h * 96 + 1 + (idx < cA ? idx : idx - cA)]);
                att::run_att_entry(C.ws, (LAS char*)C.lds, h, ent);
            }
        }
    }
}

struct Args { const float* in[16]; float* out; unsigned char* ws; int ph_lo, ph_hi; };
constexpr int N_PHASES = 12;
#ifndef FAST_MASK_V
#define FAST_MASK_V 63
#endif
constexpr int FAST_MASK = FAST_MASK_V;
#ifndef SIMPLE_ATTN_V
#define SIMPLE_ATTN_V false
#endif
constexpr bool SIMPLE_ATTN = SIMPLE_ATTN_V;

__global__ void __launch_bounds__(NTHREADS, 2) fwd_kernel(Args args) {
    extern __shared__ __attribute__((aligned(16))) unsigned char lds[];
    Ctx C;
    C.lds = (LAS unsigned char*)lds; C.tid = threadIdx.x; C.lane = C.tid & 63; C.wave = __builtin_amdgcn_readfirstlane(C.tid >> 6); C.G = gridDim.x;
    C.x = args.in[0]; C.c = args.in[1]; C.w_ada = args.in[2]; C.b_ada = args.in[3]; C.w_in = args.in[4]; C.b_forget = args.in[5]; C.w_attn_out = args.in[6]; C.w_pool = args.in[7];
    C.pool_scale = args.in[8]; C.w_out = args.in[9]; C.ln1_g = args.in[10]; C.ln1_b = args.in[11]; C.w_gate_up = args.in[12]; C.w_down = args.in[13]; C.ln2_g = args.in[14]; C.ln2_b = args.in[15];
    C.out = args.out; C.ws = args.ws;
    const int lo = args.ph_lo, hi = args.ph_hi;
    volatile LAS unsigned* MISC = (volatile LAS unsigned*)(C.lds + MISC_OFF);
    for (int u = C.tid; u < 32; u += NTHREADS) MISC[u] = 0u;
    __syncthreads();
    XcdBarrier bar = xcd_barrier_post((unsigned*)(C.ws + WS_CTL) + CW_BAR, MISC + 8);
#define IN(k) (lo <= (k) && (k) < hi)
#define SEAM(k) do { if (IN(k) && IN((k) + 1)) xcd_barrier(bar); } while (0)
    { C.tid = opaque_tid(); C.lane = C.tid & 63; if (IN(0)) ph_prologue(C); }
    SEAM(0);
    { C.tid = opaque_tid(); C.lane = C.tid & 63; if (IN(1)) ph_ln1(C); }
    SEAM(1);
    { C.tid = opaque_tid(); C.lane = C.tid & 63; if (IN(2)) { ph_flogit(C); __syncthreads();
        if constexpr (FAST_MASK & 1) { pg8::Gemm g{WSP(bf16, WS_U), WSP(bf16, WS_WZ), S, NZ, D, D, 1 << 20, 0}; pg8::StaticOrder So; So.init(S, NZ, C.G, (int)blockIdx.x);
            pg8::EpiZ E{C.ws, SIMPLE_ATTN ? WSP(bf16, WS_VT) : (bf16*)nullptr, (unsigned*)(C.ws + WS_CTL) + CW_NORM};
            pg8::gemm_phase<pg8::EpiZ, pg8::StaticOrder, true, true>(C.lds, g, So, E); }
        else { EZs E{WSP(bf16, WS_QH), WSP(bf16, WS_VT), WSP(bf16, WS_PP), WSP(bf16, WS_GA), WSP(bf16, WS_GP)};
            sgemm_phase<false>(C, WSP(bf16, WS_U), D, WSP(bf16, WS_WZ), D, S, NZ, D, 1 << 30, 0, E); } } }
    SEAM(2);
    { C.tid = opaque_tid(); C.lane = C.tid & 63; if (IN(3)) ph_scan_pool(C); }
    SEAM(3);
    { C.tid = opaque_tid(); C.lane = C.tid & 63; if (IN(4)) ph_attn_queue(C); }
    SEAM(4);
    { C.tid = opaque_tid(); C.lane = C.tid & 63; if (IN(5)) {
        for (int c = blockIdx.x; c < 16 * 24; c += C.G) att::combine_block(C.ws, c / 24, 8 + c % 24, C.tid);
        if constexpr (FAST_MASK & 2) { pg8::Gemm g{WSP(bf16, WS_PL), WSP(bf16, WS_WP), S, D, 512, PW, 4, 512}; pg8::StaticOrder So; So.init(S, D, C.G, (int)blockIdx.x);
            pg8::EpiT E{WSP(bf16, WS_GP), WSP(float, WS_T)}; pg8::gemm_phase<pg8::EpiT, pg8::StaticOrder, true, true>(C.lds, g, So, E); }
        else { ETs E{WSP(bf16, WS_GP), WSP(float, WS_T)}; sgemm_phase<false>(C, WSP(bf16, WS_PL), PW, WSP(bf16, WS_WP), 512, S, D, 512, 1024, 512, E); } } }
    SEAM(5);
    { C.tid = opaque_tid(); C.lane = C.tid & 63; if (IN(6)) {
        if constexpr (FAST_MASK & 4) { pg8::Gemm g{WSP(bf16, WS_AO), WSP(bf16, WS_WA), S, D, FW, FW, 1 << 20, 0}; pg8::StaticOrder So; So.init(S, D, C.G, (int)blockIdx.x);
            pg8::EpiM E{WSP(bf16, WS_GA), WSP(float, WS_T), WSP(bf16, WS_MX)}; pg8::gemm_phase<pg8::EpiM, pg8::StaticOrder, true, true>(C.lds, g, So, E); }
        else { EMs E{WSP(bf16, WS_GA), WSP(float, WS_T), WSP(bf16, WS_MX)}; sgemm_phase<false>(C, WSP(bf16, WS_AO), FW, WSP(bf16, WS_WA), FW, S, D, FW, 1 << 30, 0, E); } } }
    SEAM(6);
    { C.tid = opaque_tid(); C.lane = C.tid & 63; if (IN(7)) {
        if constexpr (FAST_MASK & 8) { pg8::Gemm g{WSP(bf16, WS_MX), WSP(bf16, WS_WO), S, D, D, D, 1 << 20, 0}; pg8::StaticOrder So; So.init(S, D, C.G, (int)blockIdx.x);
            pg8::EpiY E{C.x, WSP(float, WS_MOD) + 2 * D, WSP(float, WS_Y)}; pg8::gemm_phase<pg8::EpiY, pg8::StaticOrder, true, true>(C.lds, g, So, E); }
        else { EYs E{C.x, WSP(float, WS_MOD) + 2 * D, WSP(float, WS_Y)}; sgemm_phase<false>(C, WSP(bf16, WS_MX), D, WSP(bf16, WS_WO), D, S, D, D, 1 << 30, 0, E); } } }
    SEAM(7);
    { C.tid = opaque_tid(); C.lane = C.tid & 63; if (IN(8)) ph_ln_mid(C); }
    SEAM(8);
    { C.tid = opaque_tid(); C.lane = C.tid & 63; if (IN(9)) {
        if constexpr (FAST_MASK & 16) { pg8::Gemm g{WSP(bf16, WS_U), WSP(bf16, WS_WGU), S, NGU, D, D, 1 << 20, 0}; pg8::StaticOrder So; So.init(S, NGU, C.G, (int)blockIdx.x);
            pg8::EpiGU E{WSP(bf16, WS_ACT)}; pg8::gemm_phase<pg8::EpiGU, pg8::StaticOrder, true, true>(C.lds, g, So, E); }
        else { EGUs E{WSP(bf16, WS_ACT)}; sgemm_phase<true>(C, WSP(bf16, WS_U), D, WSP(bf16, WS_WGU), D, S, NGU, D, 1 << 30, 0, E); } } }
    SEAM(9);
    { C.tid = opaque_tid(); C.lane = C.tid & 63; if (IN(10)) {
        if constexpr (FAST_MASK & 32) { pg8::Gemm g{WSP(bf16, WS_ACT), WSP(bf16, WS_WD), S, D, FFN, FFN, 1 << 20, 0}; pg8::StaticOrder So; So.init(S, D, C.G, (int)blockIdx.x);
            pg8::EpiY E{WSP(float, WS_X1), WSP(float, WS_MOD) + 5 * D, WSP(float, WS_Y)}; pg8::gemm_phase<pg8::EpiY, pg8::StaticOrder, true, true>(C.lds, g, So, E); }
        else { EYs E{WSP(float, WS_X1), WSP(float, WS_MOD) + 5 * D, WSP(float, WS_Y)}; sgemm_phase<false>(C, WSP(bf16, WS_ACT), FFN, WSP(bf16, WS_WD), FFN, S, D, FFN, 1 << 30, 0, E); } } }
    SEAM(10);
    { C.tid = opaque_tid(); C.lane = C.tid & 63; if (IN(11)) ph_ln_final(C); }
#undef SEAM
#undef IN
}

extern "C" void kernel_launch(void* const* d_in, const int* in_sizes, int n_in, void* d_out, int out_size, void* d_ws, size_t ws_size, hipStream_t stream) {
    static int grid = 0;
    if (grid == 0) {
        if (n_in != 16 || in_sizes[0] != S * D || out_size != S * D || ws_size < WS_END) { fprintf(stderr, "kernel_launch: unexpected shapes (n_in %d, in0 %d, out %d, ws %zu < %zu)\n", n_in, n_in > 0 ? in_sizes[0] : -1, out_size, ws_size, (size_t)WS_END); grid = -1; return; }
        int dev = 0, cus = 0;
        if (hipGetDevice(&dev) != hipSuccess || hipDeviceGetAttribute(&cus, hipDeviceAttributeMultiprocessorCount, dev) != hipSuccess || cus <= 0) cus = 256;
        if (hipFuncSetAttribute((const void*)fwd_kernel, hipFuncAttributeMaxDynamicSharedMemorySize, LDS_BYTES) != hipSuccess) { fprintf(stderr, "kernel_launch: hipFuncSetAttribute failed\n"); grid = -1; return; }
        grid = cus;
    }
    if (grid < 0) return;
    Args a{};
    for (int i = 0; i < 16; ++i) a.in[i] = (const float*)d_in[i];
    a.out = (float*)d_out; a.ws = (unsigned char*)d_ws;
    if (hipMemsetAsync((char*)d_ws + WS_CTL, 0, CTL_ZERO_BYTES, stream) != hipSuccess) { fprintf(stderr, "kernel_launch: memset failed\n"); return; }
    a.ph_lo = 0; a.ph_hi = N_PHASES;
    hipLaunchKernelGGL(fwd_kernel, dim3(grid), dim3(NTHREADS), LDS_BYTES, stream, a);
}
```
